# Optimizing an MI355X kernel written in HIP

```python
import jax, jax.numpy as jnp
from jax import lax
import numpy as np

D_MODEL = 1024
BATCH = 8
SEQ = 8192
DEPTH = 1

CHUNK = 64
D_MIX = D_MODEL
D_RNN = D_MIX // 2
RNN_BLOCKS = 8
RNN_BLOCK = D_RNN // RNN_BLOCKS
CONV_WIDTH = 4
RG_C = 8.0
N_HEADS = 8
HEAD_DIM = 64
D_ATTN = N_HEADS * HEAD_DIM
IDX_HEADS = 8
IDX_DIM = 64
TOPK_KEYS_MAX = 256
Q_BLOCK = 128
N_EXPERTS = 32
TOPK_EXPERTS = 4
D_FF = D_MODEL
SWIGLU_ALPHA = 1.702
SWIGLU_LIMIT = 7.0
MOE_BLOCK = 256
EPS = 1e-6
IN_SPLITS = [D_RNN, D_RNN, D_ATTN, D_ATTN, D_ATTN, IDX_HEADS * IDX_DIM, IDX_DIM, IDX_HEADS]
D_IN = sum(IN_SPLITS)

kernel_name = "hybrid_rglru_dsa_moe_adaln"


def rms_norm(x, g):
    xf = x.astype(jnp.float32)
    y = xf * lax.rsqrt(jnp.mean(xf * xf, axis=-1, keepdims=True) + EPS)
    return (y * g.astype(jnp.float32)).astype(x.dtype)


def rg_lru_branch(xr, xg, conv_w, conv_b, w_a, b_a, w_x, b_x, lam):
    B, S, _ = xr.shape
    xc = lax.conv_general_dilated(
        xr, conv_w[:, None, :].astype(xr.dtype), window_strides=(1,),
        padding=[(CONV_WIDTH - 1, 0)], dimension_numbers=("NWC", "WIO", "NWC"),
        feature_group_count=D_RNN) + conv_b
    xb = xc.reshape(B, S, RNN_BLOCKS, RNN_BLOCK)
    r = jax.nn.sigmoid((jnp.einsum("bshi,hij->bshj", xb, w_a).reshape(B, S, D_RNN) + b_a).astype(jnp.float32))
    i = jax.nn.sigmoid((jnp.einsum("bshi,hij->bshj", xb, w_x).reshape(B, S, D_RNN) + b_x).astype(jnp.float32))
    log_a = -RG_C * r * jax.nn.softplus(-lam.astype(jnp.float32))
    a = jnp.exp(log_a)
    mult = jnp.sqrt(-jnp.expm1(2.0 * log_a))
    u = mult * i * xc.astype(jnp.float32)

    def combine(left, right):
        a1, b1 = left
        a2, b2 = right
        return a1 * a2, a2 * b1 + b2

    _, h = lax.associative_scan(combine, (a, u), axis=1)
    return (jax.nn.gelu(xg.astype(jnp.float32)) * h).astype(xr.dtype)


def dsa_attention(q, k, v, q_idx, k_idx, w_idx):
    B, S = q.shape[0], q.shape[1]
    n_sel = min(TOPK_KEYS_MAX, S // 4)
    n_qb = S // Q_BLOCK
    key_chunk = jnp.arange(S) // CHUNK
    k_idx_f = k_idx.astype(jnp.float32)
    gather = jax.vmap(lambda t, idx: t[idx])

    def to_blocks(t):
        return jnp.swapaxes(t.reshape((B, n_qb, Q_BLOCK) + t.shape[2:]), 0, 1)

    def one_block(args):
        qb, qib, wb, bi = args
        q_chunk = (bi * Q_BLOCK + jnp.arange(Q_BLOCK)) // CHUNK
        s = jnp.einsum("bqhd,bsd->bqhs", qib.astype(jnp.float32), k_idx_f) * (IDX_DIM ** -0.5)
        score = jnp.einsum("bqh,bqhs->bqs", wb.astype(jnp.float32) * (IDX_HEADS ** -0.5), jax.nn.relu(s))
        admissible = key_chunk[None, :] <= q_chunk[:, None]
        score = jnp.where(admissible[None], score, -jnp.inf)
        _, sel = lax.top_k(score, n_sel)
        valid = (sel // CHUNK) <= q_chunk[None, :, None]
        ks = gather(k, sel)
        vs = gather(v, sel)
        logits = jnp.einsum("bqhd,bqkhd->bqhk", qb, ks).astype(jnp.float32) * (HEAD_DIM ** -0.5)
        logits = jnp.where(valid[:, :, None, :], logits, -jnp.inf)
        p = jax.nn.softmax(logits, axis=-1).astype(v.dtype)
        return jnp.einsum("bqhk,bqkhd->bqhd", p, vs)

    out = lax.map(one_block, (to_blocks(q), to_blocks(q_idx), to_blocks(w_idx), jnp.arange(n_qb)))
    return jnp.swapaxes(out, 0, 1).reshape(B, S, D_ATTN)


def moe_ffn(h, w_router, b_router, w1, b1, w2, b2):
    T, D = h.shape
    logits = (h @ w_router + b_router).astype(jnp.float32)
    top_val, top_e = lax.top_k(logits, TOPK_EXPERTS)
    gates = jax.nn.softmax(top_val, axis=-1).astype(h.dtype)
    TK = T * TOPK_EXPERTS
    e_flat = top_e.reshape(TK)
    tok_flat = jnp.arange(TK, dtype=jnp.int32) // TOPK_EXPERTS
    order = jnp.argsort(e_flat, stable=True)
    e_sorted = e_flat[order]
    counts = jnp.bincount(e_flat, length=N_EXPERTS)
    group_start = jnp.cumsum(counts) - counts
    padded = (counts + MOE_BLOCK - 1) // MOE_BLOCK * MOE_BLOCK
    pad_end = jnp.cumsum(padded)
    pad_start = pad_end - padded
    dest = pad_start[e_sorted] + jnp.arange(TK, dtype=jnp.int32) - group_start[e_sorted]
    n_rows = TK + N_EXPERTS * MOE_BLOCK
    n_blocks = n_rows // MOE_BLOCK
    row_tok = jnp.full((n_rows,), T, jnp.int32).at[dest].set(tok_flat[order])
    row_gate = jnp.zeros((n_rows,), h.dtype).at[dest].set(gates.reshape(TK)[order])
    block_e = jnp.minimum(jnp.searchsorted(pad_end, jnp.arange(n_blocks, dtype=jnp.int32) * MOE_BLOCK, side="right"), N_EXPERTS - 1)
    h_pad = jnp.concatenate([h, jnp.zeros((1, D), h.dtype)], axis=0)

    def expert_block(args):
        tok, gate, e = args
        u = h_pad[tok] @ w1[e] + b1[e]
        u_glu = jnp.minimum(u[:, ::2], SWIGLU_LIMIT)
        u_lin = jnp.clip(u[:, 1::2], -SWIGLU_LIMIT, SWIGLU_LIMIT)
        act = u_glu * jax.nn.sigmoid(SWIGLU_ALPHA * u_glu) * (u_lin + 1)
        return (act @ w2[e] + b2[e]) * gate[:, None]

    y = lax.map(expert_block, (row_tok.reshape(n_blocks, MOE_BLOCK), row_gate.reshape(n_blocks, MOE_BLOCK), block_e))
    return jax.ops.segment_sum(y.reshape(n_rows, D), row_tok, num_segments=T + 1)[:T]


def hybrid_layer(x, c, w_ada, b_ada, norm1_g, w_in, conv_w, conv_b, w_rg_a, b_rg_a, w_rg_x, b_rg_x,
                 lru_lambda, q_norm_g, k_norm_g, kidx_norm_g, rg_out_g, attn_out_g, w_out, norm2_g,
                 w_router, b_router, w1, b1, w2, b2):
    B, S, D = x.shape
    mod = jax.nn.silu(c) @ w_ada + b_ada
    sh1, sc1, g1, sh2, sc2, g2 = jnp.split(mod[:, None, :], 6, axis=-1)
    h = rms_norm(x, norm1_g) * (1 + sc1) + sh1
    z = h @ w_in
    xr, xg, q, k, v, qi, ki, wi = jnp.split(z, [int(s) for s in np.cumsum(IN_SPLITS)[:-1]], axis=-1)
    y_rnn = rg_lru_branch(xr, xg, conv_w, conv_b, w_rg_a, b_rg_a, w_rg_x, b_rg_x, lru_lambda)
    q = rms_norm(q.reshape(B, S, N_HEADS, HEAD_DIM), q_norm_g)
    k = rms_norm(k.reshape(B, S, N_HEADS, HEAD_DIM), k_norm_g)
    v = v.reshape(B, S, N_HEADS, HEAD_DIM)
    qi = qi.reshape(B, S, IDX_HEADS, IDX_DIM)
    ki = rms_norm(ki, kidx_norm_g)
    y_attn = dsa_attention(q, k, v, qi, ki, wi)
    mix = jnp.concatenate([rms_norm(y_rnn, rg_out_g), rms_norm(y_attn, attn_out_g)], axis=-1) @ w_out
    x = x + g1 * mix
    h2 = rms_norm(x, norm2_g) * (1 + sc2) + sh2
    ff = moe_ffn(h2.reshape(B * S, D), w_router, b_router, w1, b1, w2, b2).reshape(B, S, D)
    return x + g2 * ff


def setup_inputs(seed: int = 0) -> dict:
    key = jax.random.key(seed)
    ks = jax.random.split(key, 26)
    f32 = jnp.float32
    L = DEPTH

    def nrm(k, shape, scale):
        return jax.random.normal(k, shape, f32) * scale

    a_c = jax.random.uniform(ks[12], (L, D_RNN), f32, 0.81, 0.998)
    sig = a_c ** (1.0 / RG_C)
    return {
        "x": nrm(ks[0], (BATCH, SEQ, D_MODEL), 1.0),
        "c": nrm(ks[1], (BATCH, D_MODEL), 1.0),
        "w_ada": nrm(ks[2], (L, D_MODEL, 6 * D_MODEL), 0.5 * D_MODEL ** -0.5),
        "b_ada": nrm(ks[3], (L, 6 * D_MODEL), 0.02),
        "norm1_g": 1.0 + nrm(ks[4], (L, D_MODEL), 0.02),
        "w_in": nrm(ks[5], (L, D_MODEL, D_IN), D_MODEL ** -0.5),
        "conv_w": nrm(ks[6], (L, CONV_WIDTH, D_RNN), CONV_WIDTH ** -0.5),
        "conv_b": nrm(ks[7], (L, D_RNN), 0.02),
        "w_rg_a": nrm(ks[8], (L, RNN_BLOCKS, RNN_BLOCK, RNN_BLOCK), RNN_BLOCK ** -0.5),
        "b_rg_a": nrm(ks[9], (L, D_RNN), 0.02),
        "w_rg_x": nrm(ks[10], (L, RNN_BLOCKS, RNN_BLOCK, RNN_BLOCK), RNN_BLOCK ** -0.5),
        "b_rg_x": nrm(ks[11], (L, D_RNN), 0.02),
        "lru_lambda": jnp.log(sig) - jnp.log1p(-sig),
        "q_norm_g": 1.0 + nrm(ks[13], (L, HEAD_DIM), 0.02),
        "k_norm_g": 1.0 + nrm(ks[14], (L, HEAD_DIM), 0.02),
        "kidx_norm_g": 1.0 + nrm(ks[15], (L, IDX_DIM), 0.02),
        "rg_out_g": 1.0 + nrm(ks[16], (L, D_RNN), 0.02),
        "attn_out_g": 1.0 + nrm(ks[17], (L, D_ATTN), 0.02),
        "w_out": nrm(ks[18], (L, D_MIX, D_MODEL), D_MIX ** -0.5),
        "norm2_g": 1.0 + nrm(ks[19], (L, D_MODEL), 0.02),
        "w_router": nrm(ks[20], (L, D_MODEL, N_EXPERTS), D_MODEL ** -0.5),
        "b_router": nrm(ks[21], (L, N_EXPERTS), 0.01),
        "w1": nrm(ks[22], (L, N_EXPERTS, D_MODEL, 2 * D_FF), D_MODEL ** -0.5),
        "b1": nrm(ks[23], (L, N_EXPERTS, 2 * D_FF), 0.02),
        "w2": nrm(ks[24], (L, N_EXPERTS, D_FF, D_MODEL), D_FF ** -0.5),
        "b2": nrm(ks[25], (L, N_EXPERTS, D_MODEL), 0.02),
    }


def reference(x, c, w_ada, b_ada, norm1_g, w_in, conv_w, conv_b, w_rg_a, b_rg_a, w_rg_x, b_rg_x,
              lru_lambda, q_norm_g, k_norm_g, kidx_norm_g, rg_out_g, attn_out_g, w_out, norm2_g,
              w_router, b_router, w1, b1, w2, b2):
    for l in range(DEPTH):
        x = hybrid_layer(x, c, w_ada[l], b_ada[l], norm1_g[l], w_in[l], conv_w[l], conv_b[l],
                         w_rg_a[l], b_rg_a[l], w_rg_x[l], b_rg_x[l], lru_lambda[l], q_norm_g[l],
                         k_norm_g[l], kidx_norm_g[l], rg_out_g[l], attn_out_g[l], w_out[l], norm2_g[l],
                         w_router[l], b_router[l], w1[l], b1[l], w2[l], b2[l])
    return x
```

```cpp
#include <hip/hip_runtime.h>
#include <hip/hip_bf16.h>
#include <cstdio>
#include <cstdint>

#ifndef PROBE_DUP
#define PROBE_DUP -1
#endif
#define LAS __attribute__((address_space(3)))
#define GAS __attribute__((address_space(1)))
typedef _Float16 h16;
typedef _Float16 f16x8 __attribute__((ext_vector_type(8)));
typedef _Float16 f16x4 __attribute__((ext_vector_type(4)));
typedef _Float16 f16x2 __attribute__((ext_vector_type(2)));
typedef float f32x2 __attribute__((ext_vector_type(2)));
typedef float f32x4 __attribute__((ext_vector_type(4)));
typedef float f32x16 __attribute__((ext_vector_type(16)));
typedef unsigned u32x2 __attribute__((ext_vector_type(2)));
typedef unsigned u32x4 __attribute__((ext_vector_type(4)));
typedef unsigned short u16;
typedef unsigned long long u64;
typedef __bf16 bf16x2_t __attribute__((ext_vector_type(2)));

constexpr int NB = 8, SEQ = 8192, T = NB * SEQ, D = 1024, DR = 512, DA = 512, NH = 8, HD = 64;
constexpr int NE = 32, FF = 1024, TOPK = 256;
constexpr int DIN = 3144, NIN_TILES = 13;
constexpr float EPS = 1e-6f;
constexpr float ATT_C2 = 0.125f * 1.4426950408889634f;
constexpr float IDX_WSCALE = 0.125f * 0.35355339059327373f;

constexpr size_t MiB = 1u << 20;
constexpr size_t WS_CTL = 0, CTL_ZERO_BYTES = 1 * MiB;
constexpr size_t WS_SSQ = 512 * 1024;
constexpr size_t WS_MOD = 1 * MiB;
constexpr size_t WS_SUMP = 2 * MiB, WS_SUMH = 4 * MiB;
constexpr size_t WS_WIN = 6 * MiB;
constexpr size_t WS_WOUT = 13 * MiB;
constexpr size_t WS_WRG = 15 * MiB;
constexpr size_t WS_WROUT = 15 * MiB + 256 * 1024;
constexpr size_t WS_W1 = 16 * MiB;
constexpr size_t WS_H8 = 80 * MiB;
constexpr size_t WS_W2 = 144 * MiB;
constexpr size_t WS_A = 208 * MiB;
constexpr size_t WS_XR = 336 * MiB, WS_XG = 400 * MiB, WS_Q = 464 * MiB, WS_K = 528 * MiB, WS_V = 592 * MiB, WS_QI = 656 * MiB;
constexpr size_t WS_KI = 720 * MiB, WS_WI = 728 * MiB;
constexpr size_t WS_HL = 730 * MiB, WS_AC = 794 * MiB;
constexpr size_t WS_MASK = 858 * MiB;
constexpr size_t WS_ROWINFO = 1000 * MiB;
constexpr size_t WS_LOGITS = 986 * MiB;
constexpr size_t WS_ACT = 208 * MiB;
constexpr size_t WS_Y = 472 * MiB;
constexpr size_t WS_SSQ8 = 994 * MiB;
constexpr size_t WS_TOKSLOT = 1016 * MiB;
constexpr size_t WS_END = 1017 * MiB;
constexpr int ACT_MAX_ROWS = (1024 + 32) * 256;
static_assert(WS_ACT + (size_t)ACT_MAX_ROWS * 1024 <= WS_Y && WS_Y + (size_t)ACT_MAX_ROWS * 2048 <= WS_ROWINFO, "MoE buffers");
constexpr int CW_BAR = 4096;
constexpr int CW_CNT = 32768;

constexpr int RING_OFF = 0, RING_BYTES = 131072;
constexpr int AUX_OFF = 131072;
constexpr int LDS_BYTES = 163840;
constexpr int MISC_OFF = LDS_BYTES - 256;

__device__ __forceinline__ unsigned pkh(float lo, float hi) { f32x2 v = {lo, hi}; f16x2 h = __builtin_convertvector(v, f16x2); return __builtin_bit_cast(unsigned, h); }
typedef int v8i __attribute__((ext_vector_type(8)));
constexpr float W1_F8_SCALE = 32.f, W2_F8_SCALE = 32.f, ACT_F8_SCALE = 4.f;
__device__ __forceinline__ unsigned pk4f8(float a, float b, float c, float d) { int w = 0; w = __builtin_amdgcn_cvt_pk_fp8_f32(a, b, w, false); w = __builtin_amdgcn_cvt_pk_fp8_f32(c, d, w, true); return (unsigned)w; }
__device__ __forceinline__ unsigned pk4bf8(float a, float b, float c, float d) { int w = 0; w = __builtin_amdgcn_cvt_pk_bf8_f32(a, b, w, false); w = __builtin_amdgcn_cvt_pk_bf8_f32(c, d, w, true); return (unsigned)w; }
__device__ __forceinline__ unsigned pkb(float lo, float hi) { f32x2 v = {lo, hi}; bf16x2_t h = __builtin_convertvector(v, bf16x2_t); return __builtin_bit_cast(unsigned, h); }
__device__ __forceinline__ float wave_sum(float v) {
#pragma unroll
    for (int o = 1; o < 64; o <<= 1) v += __shfl_xor(v, o);
    return v;
}
__device__ __forceinline__ float sigmoidf_(float x) { return __builtin_amdgcn_rcpf(1.f + __expf(-x)); }

#define XB_TMO      128
#define XB_XCNT(j)  (256  + 64 * (j))
#define XB_XSUB(j)  (1280 + 64 * (j))
#define XB_XGEN(j)  (2304 + 64 * (j))
#define XB_TOP      3328
#define XB_TOPGEN   3392
#define XCD_BAR_WORDS 3456
#define XB_SPIN_CAP (1u << 18)

__device__ __forceinline__ unsigned xb_ld(unsigned* p)              { return __hip_atomic_load(p, __ATOMIC_RELAXED, __HIP_MEMORY_SCOPE_AGENT); }
__device__ __forceinline__ unsigned xb_add(unsigned* p, unsigned v) { return __hip_atomic_fetch_add(p, v, __ATOMIC_RELAXED, __HIP_MEMORY_SCOPE_AGENT); }
__device__ __forceinline__ unsigned xb_xcc_id() { return (unsigned)__builtin_amdgcn_s_getreg((3 << 11) | 20) & 0xFu; }
#define XB_SPIN(cond, bar) do { unsigned _sp = 0; while (cond) { __builtin_amdgcn_s_sleep(1); \
    if ((++_sp & 255u) == 0u) { if (xb_ld(&(bar)[XB_TMO])) break; if (_sp > XB_SPIN_CAP) { atomicAdd(&(bar)[XB_TMO], 1u); break; } } } } while (0)

struct XcdBarrier { unsigned* bar; unsigned x; volatile LAS unsigned* st; };

__device__ __forceinline__ XcdBarrier xcd_barrier_post(unsigned* bar, volatile LAS unsigned* st) {
    XcdBarrier b; b.bar = bar; b.x = xb_xcc_id(); b.st = st;
    if (threadIdx.x == 0) (void)xb_add(&bar[XB_XCNT(b.x)], 1u);
    return b;
}
__device__ __forceinline__ void xcd_barrier_complete(unsigned* bar, unsigned x, unsigned& nloc, unsigned& nx) {
    const unsigned G = gridDim.x * gridDim.y * gridDim.z;
    unsigned sum, cnt, mine, sp = 0u;
    for (;;) {
        sum = 0u; cnt = 0u; mine = 0u;
#pragma unroll
        for (unsigned j = 0; j < 16; ++j) { const unsigned c = xb_ld(&bar[XB_XCNT(j)]); sum += c; cnt += (c > 0u) ? 1u : 0u; mine = (j == x) ? c : mine; }
        if (sum == G) break;
        __builtin_amdgcn_s_sleep(1);
        if ((++sp & 255u) == 0u) { if (xb_ld(&bar[XB_TMO])) break; if (sp > XB_SPIN_CAP) { atomicAdd(&bar[XB_TMO], 1u); break; } }
    }
    nloc = mine > 0u ? mine : 1u; nx = cnt > 0u ? cnt : 1u;
}
__device__ __forceinline__ void xcd_barrier(const XcdBarrier& b) {
    asm volatile("s_waitcnt vmcnt(0)" ::: "memory");
    __syncthreads();
    if (threadIdx.x == 0) {
        unsigned* bar = b.bar;
        __builtin_amdgcn_s_waitcnt(0);
        unsigned nloc = b.st[0], nx = b.st[1];
        if (nloc == 0u) { xcd_barrier_complete(bar, b.x, nloc, nx); b.st[0] = nloc; b.st[1] = nx; }
        const unsigned old = xb_add(&bar[XB_XSUB(b.x)], 1u);
        const unsigned gen = old / nloc;
        if (old + 1u == (gen + 1u) * nloc) {
            __builtin_amdgcn_fence(__ATOMIC_RELEASE, "agent");
            asm volatile("s_waitcnt vmcnt(0)" ::: "memory");
            const unsigned og = xb_add(&bar[XB_TOP], 1u);
            const unsigned tg = og / nx;
            if (og + 1u == (tg + 1u) * nx) xb_add(&bar[XB_TOPGEN], 1u);
            else XB_SPIN(xb_ld(&bar[XB_TOPGEN]) == tg, bar);
            __builtin_amdgcn_fence(__ATOMIC_ACQUIRE, "agent");
            xb_add(&bar[XB_XGEN(b.x)], 1u);
            asm volatile("s_waitcnt vmcnt(0)" ::: "memory");
        } else {
            XB_SPIN(xb_ld(&bar[XB_XGEN(b.x)]) == gen, bar);
            __builtin_amdgcn_fence(__ATOMIC_ACQUIRE, "agent");
            asm volatile("s_waitcnt vmcnt(0)" ::: "memory");
        }
    }
    __syncthreads();
}

namespace pg8 {
constexpr int BM = 256, BK = 64, HALF = 128, HTB = HALF * BK * 2, STAGE_BYTES = 8 * HTB, NXCD = 8, WGM = 8;
__host__ __device__ __forceinline__ int lds_byte(int r, int c) { const int st = (r >> 4) * 2 + (c >> 5), rr = r & 15, cc = c & 31, ob = rr * 64 + cc * 2; return st * 1024 + (ob ^ (((ob >> 9) & 1) << 5)); }
__host__ __device__ __forceinline__ void stage_rc(int b, int& R, int& C) { const int st = b / 1024, sb = b % 1024, swz = sb ^ (((sb >> 9) & 1) << 5); R = (st >> 1) * 16 + swz / 64; C = (st & 1) * 32 + (swz % 64) / 2; }
__host__ __device__ __forceinline__ int perm32(int rho) { const int n = rho >> 4, i = rho & 15; return 8 * (i >> 2) + 4 * n + (i & 3); }

struct Unit { int pm, pn, aux, ord; };

struct StaticOrder {
    int nM, nN, nwg, G, c;
    __device__ void init(int M, int N, int G_, int c_) { nM = M / BM; nN = N / BM; nwg = nM * nN; G = G_; c = c_; }
    __device__ bool next(int i, Unit& u) const {
        const long L = (long)i * G + c; if (L >= nwg) return false;
        int wgid = (int)L; { const int q = nwg / NXCD, r = nwg % NXCD, xcd = wgid % NXCD, off = wgid / NXCD; wgid = (xcd < r ? xcd * (q + 1) : r * (q + 1) + (xcd - r) * q) + off; }
        const int nig = WGM * nN, gid = wgid / nig, fm = gid * WGM, gsz = (nM - fm) < WGM ? (nM - fm) : WGM;
        u.pm = fm + ((wgid % nig) % gsz); u.pn = (wgid % nig) / gsz; u.aux = 0; u.ord = i; return true;
    }
    __device__ __forceinline__ unsigned arow(const Unit& u, int r) const { return (unsigned)(u.pm * BM + r); }
    __device__ __forceinline__ unsigned brow0(const Unit& u) const { return (unsigned)(u.pn * BM); }
};

template <bool GATHER> struct MoeSched {
    int nrt, rt_base, npn, rps, ngrp, grp, c, bstride;
    LAS const unsigned* rtg; LAS const u16* tokt;
    __device__ __forceinline__ bool next(int i, Unit& u) const { const int rr = (i * ngrp + grp) * rps + c / npn; if (rr >= nrt) return false; u.pm = rt_base + rr; u.pn = c % npn; u.aux = (int)rtg[u.pm]; u.ord = i; return true; }
    __device__ __forceinline__ unsigned arow(const Unit& u, int r) const { if constexpr (GATHER) return (unsigned)tokt[u.ord * 256 + r]; else return (unsigned)(u.pm * BM + r); }
    __device__ __forceinline__ unsigned brow0(const Unit& u) const { return (unsigned)(((u.aux >> 16) & 31) * bstride + u.pn * BM); }
};

typedef f32x4 Acc[2][2][4][2];
typedef int i32x4_ __attribute__((ext_vector_type(4)));

template <class Epi, class Sched, bool ALIGN_EPI, int MIDT, bool F8 = false>
__device__ __forceinline__ void gemm_phase(LAS unsigned char* lds, const void* A, const void* Bt, const int K, const Sched& S, const Epi& E, const unsigned apitch = 0u) {
    int tid = threadIdx.x; asm volatile("" : "+v"(tid));
    const int wid = __builtin_amdgcn_readfirstlane(tid >> 6), lane = tid & 63, wr = wid >> 2, wc = wid & 3, fr = lane & 15, fq = lane >> 4;
    constexpr int ES = F8 ? 1 : 2;
    const int nt = K * ES / (BK * 2);
    int RA[2]; unsigned CA[2], voffB[2];
#pragma unroll
    for (int i = 0; i < 2; ++i) { int R, C; stage_rc(tid * 16 + i * 8192, R, C); const int Rb = (R & ~31) + perm32(R & 31); RA[i] = R; CA[i] = (unsigned)C * 2u; voffB[i] = (unsigned)(Rb * K * ES + C * 2); }
    const size_t kstep = (size_t)(BK * 2);
    const size_t hstepB = (size_t)HALF * K * ES;
    const unsigned rowb = (unsigned)(K * ES);
    const unsigned rowa = apitch ? apitch : rowb;
    const unsigned ldsw = (unsigned)wid * 1024u;
    const int aoff = lds_byte(wr * 64 + fr, fq * 8), boff = lds_byte(wc * 32 + fr, fq * 8);
#define PG8_SA(b, h) (((b) * 2 + (h)) * HTB)
#define PG8_SB(b, h) ((4 + (b) * 2 + (h)) * HTB)
#define PG8_STAGEB(bufoff, gbase) do { _Pragma("unroll") for (int _i = 0; _i < 2; ++_i) \
        __builtin_amdgcn_global_load_lds((const unsigned*)((const char*)(gbase) + voffB[_i]), (LAS unsigned*)(lds + (bufoff) + ldsw + _i * 8192), 16, 0, 0); } while (0)
#define PG8_STAGEA(bufoff, OFFS, h, kb) do { _Pragma("unroll") for (int _i = 0; _i < 2; ++_i) \
        __builtin_amdgcn_global_load_lds((const unsigned*)((const char*)A + (size_t)(OFFS)[h][_i] + (size_t)(kb)), (LAS unsigned*)(lds + (bufoff) + ldsw + _i * 8192), 16, 0, 0); } while (0)
#define PG8_AOFFS(U, O) do { _Pragma("unroll") for (int _h = 0; _h < 2; ++_h) _Pragma("unroll") for (int _i = 0; _i < 2; ++_i) (O)[_h][_i] = S.arow(U, _h * HALF + RA[_i]) * rowa + CA[_i]; } while (0)
#define PG8_LD8(p) __builtin_shufflevector(*(const LAS i32x4_*)(p), *(const LAS i32x4_*)((p) + 1024), 0, 1, 2, 3, 4, 5, 6, 7)
#define PG8_LDA(dst, b, h) do { _Pragma("unroll") for (int m = 0; m < 4; ++m) dst[m] = PG8_LD8(lds + PG8_SA(b, h) + aoff + m * 2048); } while (0)
#define PG8_LDB(dst, b, h) do { _Pragma("unroll") for (int n = 0; n < 2; ++n) dst[n] = PG8_LD8(lds + PG8_SB(b, h) + boff + n * 2048); } while (0)
#define PG8_H0(X) __builtin_bit_cast(f16x8, __builtin_shufflevector(X, X, 0, 1, 2, 3))
#define PG8_H1(X) __builtin_bit_cast(f16x8, __builtin_shufflevector(X, X, 4, 5, 6, 7))
#define PG8_MMA(ai, bj, At, Bt_) do { __builtin_amdgcn_s_setprio(1); _Pragma("unroll") for (int m = 0; m < 4; ++m) _Pragma("unroll") for (int n = 0; n < 2; ++n) { \
        if constexpr (F8) asm volatile("v_mfma_scale_f32_16x16x128_f8f6f4 %0, %1, %2, %0, %3, %3 op_sel_hi:[0,0,0]" : "+v"(acc[ai][bj][m][n]) : "v"(Bt_[n]), "v"(At[m]), "v"(f8scale));   \
        else { acc[ai][bj][m][n] = __builtin_amdgcn_mfma_f32_16x16x32_f16(PG8_H0(Bt_[n]), PG8_H0(At[m]), acc[ai][bj][m][n], 0, 0, 0); \
               acc[ai][bj][m][n] = __builtin_amdgcn_mfma_f32_16x16x32_f16(PG8_H1(Bt_[n]), PG8_H1(At[m]), acc[ai][bj][m][n], 0, 0, 0); } } \
        __builtin_amdgcn_s_setprio(0); } while (0)
#define PG8_WAIT_V(n) asm volatile("s_waitcnt vmcnt(" #n ")" ::: "memory")
#define PG8_WAIT_L(n) asm volatile("s_waitcnt lgkmcnt(" #n ")" ::: "memory")
#define PG8_BAR __builtin_amdgcn_s_barrier()
#define PG8_SCHED __builtin_amdgcn_sched_barrier(0)
    Unit cur, nxt; int ui = 0;
    if (!S.next(0, cur)) return;
    Acc acc;
    E.acc_set(acc, E.pre(cur, wr, wc, fr, fq));
    const unsigned f8scale = 0x7f7f7f7fu;
    v8i At[4], B0[2], B1[2];
    unsigned curA[2][2], nxtA[2][2];
    PG8_AOFFS(cur, curA);
    const char* cB = (const char*)Bt + (size_t)S.brow0(cur) * rowb;
    PG8_STAGEB(PG8_SB(0, 0), cB); PG8_STAGEB(PG8_SB(0, 1), cB + hstepB); PG8_STAGEA(PG8_SA(0, 0), curA, 0, 0); PG8_STAGEA(PG8_SA(0, 1), curA, 1, 0);
    if (wr == 1) PG8_BAR;
    PG8_WAIT_V(2); PG8_BAR;
    PG8_STAGEB(PG8_SB(1, 0), cB + kstep); PG8_STAGEA(PG8_SA(1, 0), curA, 0, kstep); PG8_STAGEB(PG8_SB(1, 1), cB + hstepB + kstep);
    PG8_WAIT_V(6); PG8_BAR;
    for (;;) {
        const bool has_next = S.next(ui + 1, nxt);
        const char* nB = cB;
        if (has_next) { PG8_AOFFS(nxt, nxtA); nB = (const char*)Bt + (size_t)S.brow0(nxt) * rowb; }
        else {
#pragma unroll
            for (int h = 0; h < 2; ++h)
#pragma unroll
                for (int i = 0; i < 2; ++i) nxtA[h][i] = curA[h][i];
        }
        for (int t = 0; t < nt; t += 2) {
            const bool last = (t == nt - 2);
            const size_t kb1 = (size_t)(t + 1) * kstep;
            unsigned selA[2][2];
#pragma unroll
            for (int h = 0; h < 2; ++h)
#pragma unroll
                for (int i = 0; i < 2; ++i) selA[h][i] = last ? nxtA[h][i] : curA[h][i];
            const size_t kb2 = last ? (size_t)0 : (size_t)(t + 2) * kstep, kb3 = kb2 + kstep;
            const char* b2 = last ? nB : cB + (size_t)(t + 2) * kstep; const char* b3 = b2 + kstep;
            PG8_LDB(B0, 0, 0); PG8_LDB(B1, 0, 1); PG8_SCHED; PG8_LDA(At, 0, 0); PG8_STAGEA(PG8_SA(1, 1), curA, 1, kb1);
            PG8_WAIT_V(8); PG8_WAIT_L(0); PG8_BAR; PG8_MMA(0, 0, At, B0); PG8_MMA(0, 1, At, B1); PG8_BAR; PG8_SCHED;
            PG8_LDA(At, 0, 1); PG8_STAGEB(PG8_SB(0, 0), b2); PG8_STAGEB(PG8_SB(0, 1), b2 + hstepB); PG8_STAGEA(PG8_SA(0, 0), selA, 0, kb2);
            PG8_WAIT_V(8); PG8_WAIT_L(0); PG8_BAR; PG8_MMA(1, 0, At, B0); PG8_MMA(1, 1, At, B1); PG8_BAR; PG8_SCHED;
            PG8_LDB(B0, 1, 0); PG8_LDB(B1, 1, 1); PG8_SCHED; PG8_LDA(At, 1, 0); PG8_STAGEA(PG8_SA(0, 1), selA, 1, kb2);
            PG8_WAIT_V(8); PG8_WAIT_L(0); PG8_BAR; PG8_MMA(0, 0, At, B0); PG8_MMA(0, 1, At, B1); PG8_BAR; PG8_SCHED;
            PG8_LDA(At, 1, 1); PG8_STAGEB(PG8_SB(1, 0), b3); PG8_STAGEB(PG8_SB(1, 1), b3 + hstepB); PG8_STAGEA(PG8_SA(1, 0), selA, 0, kb3);
            PG8_WAIT_V(8); PG8_WAIT_L(0); PG8_BAR; PG8_MMA(1, 0, At, B0); PG8_MMA(1, 1, At, B1); PG8_BAR; PG8_SCHED;
            if constexpr (MIDT > 0) { if (t + 2 == MIDT) E.mid(acc, cur, wr, wc, fr, fq); }
        }
        if constexpr (ALIGN_EPI) { if (wr == 0) PG8_BAR; }
        if constexpr (F8) asm volatile("s_nop 15\n\ts_nop 15" ::: "memory");
        typename Epi::Pre pre_; if (has_next) pre_ = E.pre(nxt, wr, wc, fr, fq);
        if constexpr (PROBE_DUP == Epi::PID) E(acc, cur, wr, wc, fr, fq);
        E(acc, cur, wr, wc, fr, fq);
        if (!has_next) break;
        E.acc_set(acc, pre_);
        cur = nxt; cB = nB; ++ui;
#pragma unroll
        for (int h = 0; h < 2; ++h)
#pragma unroll
            for (int i = 0; i < 2; ++i) curA[h][i] = nxtA[h][i];
        if constexpr (ALIGN_EPI) { if (wr == 1) PG8_BAR; }
    }
    PG8_WAIT_V(0);
    if constexpr (!ALIGN_EPI) { if (wr == 0) PG8_BAR; }
    PG8_BAR;
#undef PG8_SA
#undef PG8_SB
#undef PG8_STAGEA
#undef PG8_STAGEB
#undef PG8_AOFFS
#undef PG8_LDA
#undef PG8_LDB
#undef PG8_MMA
#undef PG8_H0
#undef PG8_H1
#undef PG8_LD8
#undef PG8_WAIT_V
#undef PG8_WAIT_L
#undef PG8_BAR
#undef PG8_SCHED
}

__device__ __forceinline__ u32x4 pack8h(const f32x4 a, const f32x4 b) { u32x4 w; w.x = pkh(a[0], a[1]); w.y = pkh(a[2], a[3]); w.z = pkh(b[0], b[1]); w.w = pkh(b[2], b[3]); return w; }
__device__ __forceinline__ u32x4 pack8b(const f32x4 a, const f32x4 b) { u32x4 w; w.x = pkb(a[0], a[1]); w.y = pkb(a[2], a[3]); w.z = pkb(b[0], b[1]); w.w = pkb(b[2], b[3]); return w; }

struct NoPre {};
__device__ __forceinline__ void acc_zero(Acc& acc) {
#pragma unroll
    for (int a = 0; a < 2; ++a)
#pragma unroll
        for (int b = 0; b < 2; ++b)
#pragma unroll
            for (int m = 0; m < 4; ++m)
#pragma unroll
                for (int n = 0; n < 2; ++n) acc[a][b][m][n] = (f32x4){0.f, 0.f, 0.f, 0.f};
}
struct EpiInProj { static constexpr int PID = 21;
    typedef NoPre Pre;
    __device__ __forceinline__ Pre pre(const Unit&, int, int, int, int) const { return Pre{}; }
    __device__ __forceinline__ void acc_set(Acc& acc, const Pre&) const { acc_zero(acc); }
    u16* base; h16* KI; float* WI; const float *qg, *kg, *kig;
    __device__ __forceinline__ void mid(Acc&, const Unit&, int, int, int, int) const {}
    __device__ __forceinline__ void headnorm(const Acc& acc, const size_t row0, int fq, const float* g, float sc, u16* dst, int pitch, int coloff, bool bf) const {
        f32x4 gv[2][2];
#pragma unroll
        for (int bj = 0; bj < 2; ++bj)
#pragma unroll
            for (int n = 0; n < 2; ++n) gv[bj][n] = *(const f32x4*)(g + 32 * bj + 8 * fq + 4 * n);
#pragma unroll
        for (int ai = 0; ai < 2; ++ai)
#pragma unroll
            for (int m = 0; m < 4; ++m) {
                float ss = 0.f;
#pragma unroll
                for (int bj = 0; bj < 2; ++bj)
#pragma unroll
                    for (int n = 0; n < 2; ++n) { const f32x4 v = acc[ai][bj][m][n]; ss += (v[0] * v[0] + v[1] * v[1]) + (v[2] * v[2] + v[3] * v[3]); }
                ss += __shfl_xor(ss, 16); ss += __shfl_xor(ss, 32);
                const float rs = rsqrtf(ss * (1.f / 64.f) + EPS) * sc;
                u16* rowp = dst + (row0 + ai * 128 + m * 16) * (size_t)pitch + coloff + 8 * fq;
#pragma unroll
                for (int bj = 0; bj < 2; ++bj) {
                    const f32x4 v0 = acc[ai][bj][m][0] * rs * gv[bj][0], v1 = acc[ai][bj][m][1] * rs * gv[bj][1];
                    *(u32x4*)(rowp + 32 * bj) = bf ? pack8b(v0, v1) : pack8h(v0, v1);
                }
            }
    }
    __device__ __forceinline__ void operator()(const Acc& acc, const Unit& u, int wr, int wc, int fr, int fq) const {
        const int pn = u.pn; const size_t row0 = (size_t)u.pm * 256 + wr * 64 + fr;
        u16* dst = base + (size_t)(pn >> 1) * (size_t)(32u << 20);
        if (pn < 4 || (pn >= 8 && pn < 12)) {
            const bool isbf = (pn == 8 || pn == 9);
            const int col0 = (pn & 1) * 256 + wc * 32 + 8 * fq;
#pragma unroll
            for (int ai = 0; ai < 2; ++ai)
#pragma unroll
                for (int m = 0; m < 4; ++m) {
                    u16* rowp = dst + (row0 + ai * 128 + m * 16) * 512 + col0;
#pragma unroll
                    for (int bj = 0; bj < 2; ++bj) *(u32x4*)(rowp + bj * 128) = isbf ? pack8b(acc[ai][bj][m][0], acc[ai][bj][m][1]) : pack8h(acc[ai][bj][m][0], acc[ai][bj][m][1]);
                }
        } else if (pn < 8) {
            const bool isq = pn < 6;
            headnorm(acc, row0, fq, isq ? qg : kg, isq ? ATT_C2 : 1.f, dst, 512, ((pn & 1) * 4 + wc) * 64, true);
        } else {
            if (wc == 0) headnorm(acc, row0, fq, kig, 1.f, (u16*)KI, 64, 0, false);
            else if (wc == 1 && fq == 0) {
#pragma unroll
                for (int ai = 0; ai < 2; ++ai)
#pragma unroll
                    for (int m = 0; m < 4; ++m) { float* p = WI + (row0 + ai * 128 + m * 16) * 8; *(f32x4*)p = acc[ai][0][m][0]; *(f32x4*)(p + 4) = acc[ai][0][m][1]; }
            }
        }
    }
};

struct EpiOutProj { static constexpr int PID = 51;
    typedef NoPre Pre;
    __device__ __forceinline__ Pre pre(const Unit&, int, int, int, int) const { return Pre{}; }
    __device__ __forceinline__ void acc_set(Acc& acc, const Pre&) const { acc_zero(acc); }
    const float* x; float* out; const float* mod; LAS const float* rstd;
    __device__ __forceinline__ void mid(Acc& acc, const Unit& u, int wr, int wc, int fr, int fq) const {
#pragma unroll
        for (int ai = 0; ai < 2; ++ai)
#pragma unroll
            for (int m = 0; m < 4; ++m) {
                const float s = rstd[u.ord * 256 + ai * 128 + wr * 64 + m * 16 + fr];
#pragma unroll
                for (int bj = 0; bj < 2; ++bj)
#pragma unroll
                    for (int n = 0; n < 2; ++n) acc[ai][bj][m][n] = acc[ai][bj][m][n] * s;
            }
    }
    __device__ __forceinline__ void operator()(const Acc& acc, const Unit& u, int wr, int wc, int fr, int fq) const {
        const int b = u.pm >> 5; const int col0 = u.pn * 256 + wc * 32 + 8 * fq;
        const float* g1 = mod + b * 6144 + 2048 + col0;
        f32x4 gv[2][2];
#pragma unroll
        for (int bj = 0; bj < 2; ++bj)
#pragma unroll
            for (int n = 0; n < 2; ++n) gv[bj][n] = *(const f32x4*)(g1 + bj * 128 + 4 * n);
#pragma unroll
        for (int ai = 0; ai < 2; ++ai)
#pragma unroll
            for (int mh = 0; mh < 2; ++mh) {
                f32x4 xv[2][2][2]; size_t off[2];
#pragma unroll
                for (int q = 0; q < 2; ++q) { off[q] = ((size_t)u.pm * 256 + ai * 128 + wr * 64 + (2 * mh + q) * 16 + fr) * 1024 + col0;
#pragma unroll
                    for (int bj = 0; bj < 2; ++bj)
#pragma unroll
                        for (int n = 0; n < 2; ++n) xv[q][bj][n] = *(const f32x4*)(x + off[q] + bj * 128 + 4 * n); }
#pragma unroll
                for (int q = 0; q < 2; ++q)
#pragma unroll
                    for (int bj = 0; bj < 2; ++bj)
                        *(u32x4*)((h16*)out + 2 * off[q] - col0 + 1024 + bj * 128) = pack8h(xv[q][bj][0] + gv[bj][0] * acc[ai][bj][2 * mh + q][0], xv[q][bj][1] + gv[bj][1] * acc[ai][bj][2 * mh + q][1]);
            }
    }
};


struct EpiGemm1 { static constexpr int PID = 91;
    struct Pre { f32x4 v[4]; };
    __device__ __forceinline__ Pre pre(const Unit& u, int wr, int wc, int fr, int fq) const {
        const int e = (u.aux >> 16) & 31; const int f0 = u.pn * 128 + wc * 32 + 8 * fq; const float* bb = b1 + (size_t)e * 2048 + 2 * f0;
        Pre p;
#pragma unroll
        for (int q = 0; q < 4; ++q) p.v[q] = *(const f32x4*)(bb + 4 * q);
        return p; }
    __device__ __forceinline__ void acc_set(Acc& acc, const Pre& p) const {
#pragma unroll
        for (int q = 0; q < 4; ++q) {
            const float g0 = p.v[q][0] * W1_F8_SCALE, l0 = p.v[q][1] * W1_F8_SCALE, g1 = p.v[q][2] * W1_F8_SCALE, l1 = p.v[q][3] * W1_F8_SCALE;
#pragma unroll
            for (int ai = 0; ai < 2; ++ai)
#pragma unroll
                for (int m = 0; m < 4; ++m) { acc[ai][0][m][q >> 1][(2 * q) & 3] = g0; acc[ai][0][m][q >> 1][((2 * q) & 3) + 1] = g1; acc[ai][1][m][q >> 1][(2 * q) & 3] = l0; acc[ai][1][m][q >> 1][((2 * q) & 3) + 1] = l1; }
        } }
    unsigned char* act; const float* b1;
    __device__ __forceinline__ void mid(Acc&, const Unit&, int, int, int, int) const {}
    __device__ __forceinline__ void operator()(const Acc& acc, const Unit& u, int wr, int wc, int fr, int fq) const {
        const int e = (u.aux >> 16) & 31; const int f0 = u.pn * 128 + wc * 32 + 8 * fq;
#pragma unroll
        for (int ai = 0; ai < 2; ++ai)
#pragma unroll
            for (int m = 0; m < 4; ++m) {
                float o[8];
#pragma unroll
                for (int j = 0; j < 8; ++j) {
                    const float ug = acc[ai][0][m][j >> 2][j & 3] * (1.f / W1_F8_SCALE), ul = acc[ai][1][m][j >> 2][j & 3] * (1.f / W1_F8_SCALE);
                    const float glu = fminf(ug, 7.f), lin = fminf(fmaxf(ul, -7.f), 7.f);
                    o[j] = (glu * __builtin_amdgcn_rcpf(1.f + __builtin_amdgcn_exp2f(glu * (-1.702f * 1.4426950408889634f)))) * __builtin_fmaf(lin, ACT_F8_SCALE, ACT_F8_SCALE);
                }
                u32x2 w; w.x = pk4f8(o[0], o[1], o[2], o[3]); w.y = pk4f8(o[4], o[5], o[6], o[7]);
                *(u32x2*)(act + ((size_t)u.pm * 256 + ai * 128 + wr * 64 + m * 16 + fr) * 1024 + f0) = w;
            }
    }
};

struct EpiGemm2 { static constexpr int PID = 101;
    struct Pre { f32x4 v[2][2]; };
    __device__ __forceinline__ Pre pre(const Unit& u, int wr, int wc, int fr, int fq) const {
        const int e = (u.aux >> 16) & 31; const int col0 = u.pn * 256 + wc * 32 + 8 * fq;
        Pre p;
#pragma unroll
        for (int bj = 0; bj < 2; ++bj)
#pragma unroll
            for (int k = 0; k < 2; ++k) p.v[bj][k] = *(const f32x4*)(b2 + (size_t)e * 1024 + col0 + bj * 128 + 4 * k);
        return p; }
    __device__ __forceinline__ void acc_set(Acc& acc, const Pre& p) const {
#pragma unroll
        for (int ai = 0; ai < 2; ++ai)
#pragma unroll
            for (int bj = 0; bj < 2; ++bj)
#pragma unroll
                for (int m = 0; m < 4; ++m)
#pragma unroll
                    for (int k = 0; k < 2; ++k) acc[ai][bj][m][k] = p.v[bj][k] * (W2_F8_SCALE * ACT_F8_SCALE);
    }
    unsigned char* y; const float* b2; LAS const unsigned* rtab; LAS const unsigned* cnt;
    __device__ __forceinline__ void mid(Acc&, const Unit&, int, int, int, int) const {}
    __device__ __forceinline__ void operator()(const Acc& acc, const Unit& u, int wr, int wc, int fr, int fq) const {
        const int g = (u.aux >> 16) & 127, mt = u.aux & 0xffff, e = g & 31; const int n = (int)cnt[g];
        const int col0 = u.pn * 256 + wc * 32 + 8 * fq;
        LAS const unsigned* rt = rtab + u.ord * 256 + wr * 64 + fr;
#pragma unroll
        for (int ai = 0; ai < 2; ++ai)
#pragma unroll
            for (int m = 0; m < 4; ++m) {
                const int r = ai * 128 + m * 16;
                if (mt * 256 + r + wr * 64 + fr < n) {
                    const unsigned ri = rt[r];
                    f16x2 gh = __builtin_bit_cast(f16x2, ri); const float gate = (float)gh[1];
                    const float gc = gate * (1.f / (W2_F8_SCALE * ACT_F8_SCALE));
                    unsigned char* p = y + ((size_t)u.pm * 256 + r + wr * 64 + fr) * 1024 + col0;
#pragma unroll
                    for (int bj = 0; bj < 2; ++bj) {
                        const f32x4 y0 = acc[ai][bj][m][0] * gc, y1 = acc[ai][bj][m][1] * gc;
                        u32x2 w; w.x = pk4bf8(y0[0], y0[1], y0[2], y0[3]); w.y = pk4bf8(y1[0], y1[1], y1[2], y1[3]);
                        *(u32x2*)(p + bj * 128) = w;
                    }
                }
            }
    }
};
}

namespace attn_body {
using bf16=__hip_bfloat16;
using bf16x8=__attribute__((ext_vector_type(8)))short;
using s16x4=__attribute__((ext_vector_type(4)))short;
using f32x16=__attribute__((ext_vector_type(16)))float;
using u32x4=__attribute__((ext_vector_type(4)))unsigned;
constexpr int BATCH=8,NHEAD=8,SEQ=8192,D=64,DM=NHEAD*D,OPITCH=1024;
constexpr int NW=8,QBLK=32,QB=QBLK*NW,KVBLK=64,NQB=SEQ/QB;
constexpr int ATTN_PITCH=DM, ATTN_UNIT_ROWS=QB;
__device__ __forceinline__ int crow(int r,int hi){return (r&3)+8*(r>>2)+4*hi;}
#define SBAR() __builtin_amdgcn_sched_barrier(0)
__device__ __forceinline__ void cmask(f32x16&p0,f32x16&p1,int jb,int qrel,int hi){
  const float NEG=-INFINITY; int kb=64*jb+4*hi;
  #pragma unroll
  for(int r=0;r<16;++r){int kv=kb+(r&3)+8*(r>>2); if(kv>qrel)p0[r]=NEG; if(kv+32>qrel)p1[r]=NEG;}
}

constexpr int NSLOT=3, SLOTB=8192;
constexpr int LDS_K=0, LDS_V=NSLOT*SLOTB, LDS_WS=2*NSLOT*SLOTB, LDS_OST=LDS_WS+NW*64*4, LDS_BYTES=LDS_OST+NW*4096;
constexpr float C2=0.125f*1.4426950408889634f;
__device__ __forceinline__ void glds16(const void*gsrc,unsigned lds_dst){unsigned keep;
  asm volatile("s_mov_b32 %0, m0\n\ts_mov_b32 m0, %2\n\ts_nop 0\n\tglobal_load_lds_dwordx4 %1, off\n\ts_mov_b32 m0, %0":"=&s"(keep):"v"(gsrc),"s"(lds_dst):"memory");}
template<int C> __device__ __forceinline__ unsigned mbfe(unsigned w){unsigned m;asm("v_bfe_i32 %0, %1, %2, 1":"=v"(m):"v"(w),"n"(C));return m;}
__device__ __forceinline__ void glds4(const void*gsrc,unsigned lds_dst){unsigned keep;
  asm volatile("s_mov_b32 %0, m0\n\ts_mov_b32 m0, %2\n\ts_nop 0\n\tglobal_load_lds_dword %1, off\n\ts_mov_b32 m0, %0":"=&s"(keep):"v"(gsrc),"s"(lds_dst):"memory");}
__device__ __forceinline__ float max3f(float a,float b,float c){float r;asm("v_max3_f32 %0, %1, %2, %3":"=v"(r):"v"(a),"v"(b),"v"(c));return r;}
__device__ __forceinline__ float max2f(float a,float b){float r;asm("v_max_f32_e32 %0, %1, %2":"=v"(r):"v"(a),"v"(b));return r;}
__device__ __forceinline__ float fadd_s(float a,float b){float r;asm("v_add_f32_e32 %0, %1, %2":"=v"(r):"v"(a),"v"(b));return r;}
__device__ __forceinline__ float fsub_s(float a,float b){float r;asm("v_sub_f32_e32 %0, %1, %2":"=v"(r):"v"(a),"v"(b));return r;}
typedef float f32x2_t __attribute__((ext_vector_type(2))); typedef __bf16 bf16x2_t __attribute__((ext_vector_type(2)));
__device__ __forceinline__ unsigned cvtpk_s(float lo,float hi){f32x2_t v={lo,hi};bf16x2_t b=__builtin_convertvector(v,bf16x2_t);return __builtin_bit_cast(unsigned,b);}
#define WAIT_BAR(N) asm volatile("s_waitcnt vmcnt(" #N ") lgkmcnt(0)\n\ts_barrier":::"memory")

__device__ __forceinline__ void qkt(f32x16&p0,f32x16&p1,const char*Kslot,const bf16x8*qr,const f32x16&negm,int r32,int hi){
  const char*kb=Kslot+hi*1024+r32*16;
  #pragma unroll
  for(int d0=0;d0<4;++d0){
    const bf16x8 b0=*reinterpret_cast<const bf16x8*>(kb+d0*2048);
    const bf16x8 b1=*reinterpret_cast<const bf16x8*>(kb+d0*2048+512);
    if(d0==0){p0=__builtin_amdgcn_mfma_f32_32x32x16_bf16(b0,qr[0],negm,0,0,0);p1=__builtin_amdgcn_mfma_f32_32x32x16_bf16(b1,qr[0],negm,0,0,0);}
    else{p0=__builtin_amdgcn_mfma_f32_32x32x16_bf16(b0,qr[d0],p0,0,0,0);p1=__builtin_amdgcn_mfma_f32_32x32x16_bf16(b1,qr[d0],p1,0,0,0);}}
}
typedef __attribute__((address_space(3))) const char* lds_cptr;
typedef short v4i16_t __attribute__((ext_vector_type(4)));
__device__ __forceinline__ void kload8(bf16x8*kf,lds_cptr kp){
  kf[0]=*(const __attribute__((address_space(3))) bf16x8*)(kp);      kf[1]=*(const __attribute__((address_space(3))) bf16x8*)(kp+512);
  kf[2]=*(const __attribute__((address_space(3))) bf16x8*)(kp+2048); kf[3]=*(const __attribute__((address_space(3))) bf16x8*)(kp+2560);
  kf[4]=*(const __attribute__((address_space(3))) bf16x8*)(kp+4096); kf[5]=*(const __attribute__((address_space(3))) bf16x8*)(kp+4608);
  kf[6]=*(const __attribute__((address_space(3))) bf16x8*)(kp+6144); kf[7]=*(const __attribute__((address_space(3))) bf16x8*)(kp+6656);
}
__device__ __forceinline__ void kload2(bf16x8*kf,lds_cptr kp,int j){ kf[2*j]=*(const __attribute__((address_space(3))) bf16x8*)(kp+j*2048); kf[2*j+1]=*(const __attribute__((address_space(3))) bf16x8*)(kp+j*2048+512); }
__device__ __forceinline__ s16x4 vtr(lds_cptr p){ return __builtin_bit_cast(s16x4,__builtin_amdgcn_ds_read_tr16_b64_v4i16((__attribute__((address_space(3))) v4i16_t*)p)); }
__device__ __forceinline__ float rowmax(const f32x16&p0,const f32x16&p1){
  float a=max3f(p0[0],p0[1],p1[0]),b=max3f(p0[2],p0[3],p1[1]);a=max3f(a,p1[2],p1[3]);
  #pragma unroll
  for(int r=4;r<16;r+=4){a=max3f(a,p0[r],p0[r+1]);b=max3f(b,p0[r+2],p0[r+3]);a=max3f(a,p1[r],p1[r+1]);b=max3f(b,p1[r+2],p1[r+3]);}
  const float m=max2f(a,b);
  auto rr=__builtin_amdgcn_permlane32_swap(__float_as_uint(m),__float_as_uint(m),false,false);
  return max2f(__uint_as_float(rr[0]),__uint_as_float(rr[1]));
}
__device__ __forceinline__ void pv(f32x16*o,int vb,bf16x8 pa0,bf16x8 pa1,bf16x8 pa2,bf16x8 pa3){
  #pragma unroll
  for(int d0=0;d0<2;++d0){s16x4 lo[4],hi[4];
    #pragma unroll
    for(int ks=0;ks<4;++ks){
      asm volatile("ds_read_b64_tr_b16 %0,%1 offset:%c2":"=&v"(lo[ks]):"v"(vb),"i"(d0*4096+ks*1024):"memory");
      asm volatile("ds_read_b64_tr_b16 %0,%1 offset:%c2":"=&v"(hi[ks]):"v"(vb),"i"(d0*4096+ks*1024+512):"memory");}
    asm volatile("s_waitcnt lgkmcnt(0)":::"memory");SBAR();
    #define PK(k) (bf16x8){lo[k][0],lo[k][1],lo[k][2],lo[k][3],hi[k][0],hi[k][1],hi[k][2],hi[k][3]}
    o[d0]=__builtin_amdgcn_mfma_f32_32x32x16_bf16(pa0,PK(0),o[d0],0,0,0);
    o[d0]=__builtin_amdgcn_mfma_f32_32x32x16_bf16(pa1,PK(1),o[d0],0,0,0);
    o[d0]=__builtin_amdgcn_mfma_f32_32x32x16_bf16(pa2,PK(2),o[d0],0,0,0);
    o[d0]=__builtin_amdgcn_mfma_f32_32x32x16_bf16(pa3,PK(3),o[d0],0,0,0);
    #undef PK
  }
}

#ifndef ATTN_STORE16
#define ATTN_STORE16(p,v) (*(u32x4*)(p)=(v))
#endif
template<int THRL> __device__ __forceinline__ void attn_unit(int b,int h,int qb,const bf16*Q,const bf16*__restrict__ K,const bf16*__restrict__ V,_Float16*O,const unsigned*MASKP,float*SSQ,char*shm){
  int tid=threadIdx.x; asm volatile("":"+v"(tid)); const int lane=tid&63,r32=lane&31,hi=lane>>5; const int wid=__builtin_amdgcn_readfirstlane(tid>>6);
  const long rowbase=(long)b*SEQ; const int q0=qb*QB;
  const bf16*Qw=Q+(rowbase+q0+wid*QBLK)*DM+h*D;
  const bf16*Kh=K+rowbase*DM+h*D,*Vh=V+rowbase*DM+h*D;
  const unsigned lds0=(unsigned)(uintptr_t)shm;
  float*wsf=(float*)(shm+LDS_WS)+wid*64;
  const bf16*ksrc=Kh+(long)lane*DM+wid*8;
  const bf16*vsrc=Vh+(long)(16*(wid&3)+(lane>>2))*DM+(wid>>2)*32+(lane&3)*8;
  const unsigned kdst=lds0+LDS_K+wid*1024, vdst=lds0+LDS_V+wid*1024;
  #define DMA_K(t,slot) glds16(ksrc+(long)(t)*KVBLK*DM,(unsigned)__builtin_amdgcn_readfirstlane(kdst+(slot)))
  #define DMA_V(t,slot) glds16(vsrc+(long)(t)*KVBLK*DM,(unsigned)__builtin_amdgcn_readfirstlane(vdst+(slot)))
  const int vb0=(int)(lds0+LDS_V)+((lane>>4)&1)*32+(lane&3)*8+(4*hi+((lane&15)>>2))*64;
  const char*Kbase=shm+LDS_K; bf16x8 kf[8];
  const lds_cptr shm3=(lds_cptr)shm; const lds_cptr kp0=shm3+LDS_K+hi*1024+r32*16; const lds_cptr vp0=shm3+LDS_V+((lane>>4)&1)*32+(lane&3)*8+(4*hi+((lane&15)>>2))*64;
  const int NT=(q0+QB)/KVBLK;
  const unsigned*mrow=MASKP+(size_t)(rowbase+q0+wid*QBLK+(lane>>1))*256+(lane&1);
  const unsigned mdst=lds0+LDS_BYTES+wid*512;
  const lds_cptr mrd=(lds_cptr)shm+LDS_BYTES+wid*512+r32*8;
  #define MLOAD(t) glds4(mrow+2*(t),(unsigned)__builtin_amdgcn_readfirstlane(mdst+((t)&1)*256))
  #define MWORDS(t) (*(const __attribute__((address_space(3))) unsigned long long*)(mrd+((t)&1)*256))
  #define MBIT(r) (((r)&3)+8*((r)>>2))
  #define MAND(v,w,c) __uint_as_float(__float_as_uint(v)&mbfe<(c)>(w))
  #define MAND0(v,w,c) __uint_as_float(__float_as_uint(v)&(unsigned)(((int)((w)<<(31-(c))))>>31))
  MLOAD(0);MLOAD(1);
  DMA_K(0,0);DMA_V(0,0);DMA_K(1,SLOTB);
  bf16x8 qr[4];
  #pragma unroll
  for(int d0=0;d0<4;++d0)qr[d0]=*reinterpret_cast<const bf16x8*>(&Qw[(long)r32*DM+d0*16+hi*8]);
  float mhat=0.f,l_reg=0.f;f32x16 o[2];o[0]=f32x16{};o[1]=f32x16{};const f32x16 negm=f32x16{};
  const int qrel=wid*QBLK+r32;
  #define CMASK(P0,P1,t) do{int jb_=(t)-(NT-4); if(jb_>(wid>>1)){_Pragma("unroll") for(int r_=0;r_<16;++r_){P0[r_]=-INFINITY;P1[r_]=-INFINITY;}}}while(0)
  bool resc=false;
  #define START(P0,P1) do{ _Pragma("unroll") for(int r=0;r<16;++r)P0[r]=__builtin_amdgcn_exp2f(P0[r]); }while(0)
  #define RESC() do{ if(resc){ asm volatile("s_waitcnt lgkmcnt(0)":::"memory"); \
      _Pragma("unroll") for(int d_=0;d_<2;++d_) _Pragma("unroll") for(int r=0;r<16;++r)o[d_][r]*=wsf[crow(r,hi)]; } }while(0)
  f32x16 pA0,pA1,pB0,pB1;
  int sl_prev=0,sl_cur=0,sl_next=SLOTB;
  #define ROT() do{sl_prev=sl_cur;sl_cur=sl_next;sl_next=(sl_next==(NSLOT-1)*SLOTB)?0:sl_next+SLOTB;}while(0)
  DMA_K(2,2*SLOTB);
  WAIT_BAR(3);
  qkt(pA0,pA1,Kbase,qr,negm,r32,hi);asm volatile("s_nop 15\n\ts_nop 7":"+v"(pA0),"+v"(pA1));CMASK(pA0,pA1,0);
  START(pA0,pA1);
  _Pragma("unroll") for(int r=0;r<16;++r)pA1[r]=__builtin_amdgcn_exp2f(pA1[r]);
  { const unsigned long long mw_=MWORDS(0); const unsigned w0_=(unsigned)mw_>>(4*hi), w1_=(unsigned)(mw_>>32)>>(4*hi);
    _Pragma("unroll") for(int r=0;r<16;++r){pA0[r]=MAND0(pA0[r],w0_,MBIT(r));pA1[r]=MAND0(pA1[r],w1_,MBIT(r));} }
  WAIT_BAR(0);
  DMA_K(3,0);DMA_V(1,SLOTB);
  ROT();
  kload8(kf,kp0+sl_cur);
  WAIT_BAR(2);
  s16x4 vlo[8],vhi[8]; u32x4 pw0,pw1,pw2,pw3;
  #define PKW(P,B) cvtpk_s(P[B],P[B+1])
  #define PAF(k) __builtin_bit_cast(bf16x8,pw##k)
  #define VFR(i) (bf16x8){vlo[i][0],vlo[i][1],vlo[i][2],vlo[i][3],vhi[i][0],vhi[i][1],vhi[i][2],vhi[i][3]}
  #define PIN(x) asm volatile("":"+v"(x))
  #define MX3(a,b,c) __builtin_fmaxf(__builtin_fmaxf((a),(b)),(c))
  #define GAPA(MF,A0,A1,A2,A3,W0,W1,PW) do{ MF; sacc+=A0; sacc+=A1; sacc+=A2; sacc+=A3; PIN(sacc); W0; W1; PIN(PW); SBAR(); }while(0)
  #define EX(v) __builtin_amdgcn_exp2f(v)
  #define GAPB(MF,X,B,W) do{ MF; X[B]=MAND(EX(X[B]),W,MBIT(B)); X[B+1]=MAND(EX(X[B+1]),W,MBIT(B+1)); X[B+2]=MAND(EX(X[B+2]),W,MBIT(B+2)); X[B+3]=MAND(EX(X[B+3]),W,MBIT(B+3)); PIN(X); SBAR(); }while(0)
  #define VRD(i) do{ vlo[i]=vtr(vp_+(((i)>>2)*4096+((i)&3)*1024)); vhi[i]=vtr(vp_+(((i)>>2)*4096+((i)&3)*1024+512)); }while(0)
  #define KRD(G,j) do{ if(G){ kload2(kf,kp0+sl_next,j); SBAR(); } }while(0)
  #define STEP(C0,C1,P0,P1,t,GK,GV,GL,GM) do{ if(GM){MLOAD((t)+1);} SBAR(); \
    const lds_cptr vp_=vp0+sl_prev; \
    VRD(0); SBAR(); float sacc=(P0[0]+P0[1]); \
    GAPA(C0=__builtin_amdgcn_mfma_f32_32x32x16_bf16(kf[0],qr[0],negm,0,0,0), P0[2],P0[3],P0[4],P0[5],     pw0[0]=PKW(P0,0), pw0[1]=PKW(P0,2), pw0); \
    VRD(4); SBAR(); GAPA(C1=__builtin_amdgcn_mfma_f32_32x32x16_bf16(kf[1],qr[0],negm,0,0,0), P0[6],P0[7],P0[8],P0[9],     pw0[2]=PKW(P0,4), pw0[3]=PKW(P0,6), pw0); \
    VRD(1); SBAR(); GAPA(C0=__builtin_amdgcn_mfma_f32_32x32x16_bf16(kf[2],qr[1],C0,0,0,0),   P0[10],P0[11],P0[12],P0[13], pw1[0]=PKW(P0,8), pw1[1]=PKW(P0,10), pw1); \
    VRD(5); SBAR(); GAPA(C1=__builtin_amdgcn_mfma_f32_32x32x16_bf16(kf[3],qr[1],C1,0,0,0),   P0[14],P0[15],P1[0],P1[1],   pw1[2]=PKW(P0,12),pw1[3]=PKW(P0,14), pw1); \
    VRD(2); SBAR(); GAPA(C0=__builtin_amdgcn_mfma_f32_32x32x16_bf16(kf[4],qr[2],C0,0,0,0),   P1[2],P1[3],P1[4],P1[5],     pw2[0]=PKW(P1,0), pw2[1]=PKW(P1,2), pw2); \
    VRD(6); SBAR(); GAPA(C1=__builtin_amdgcn_mfma_f32_32x32x16_bf16(kf[5],qr[2],C1,0,0,0),   P1[6],P1[7],P1[8],P1[9],     pw2[2]=PKW(P1,4), pw2[3]=PKW(P1,6), pw2); \
    VRD(3); SBAR(); GAPA(C0=__builtin_amdgcn_mfma_f32_32x32x16_bf16(kf[6],qr[3],C0,0,0,0),   P1[10],P1[11],P1[12],P1[13], pw3[0]=PKW(P1,8), pw3[1]=PKW(P1,10), pw3); \
    VRD(7); SBAR(); GAPA(C1=__builtin_amdgcn_mfma_f32_32x32x16_bf16(kf[7],qr[3],C1,0,0,0),   P1[14],P1[15],0.f,0.f,       pw3[2]=PKW(P1,12),pw3[3]=PKW(P1,14), pw3); \
    l_reg+=sacc; \
    if(GK){DMA_K((t)+3,sl_cur);} if(GV){DMA_V((t)+1,sl_next);} \
    CMASK(C0,C1,t); \
    const unsigned long long mw_=MWORDS(t); const unsigned w0_=(unsigned)mw_>>(4*hi), w1_=(unsigned)(mw_>>32)>>(4*hi); \
    SBAR(); \
    GAPB(o[0]=__builtin_amdgcn_mfma_f32_32x32x16_bf16(PAF(0),VFR(0),o[0],0,0,0), C0,0,w0_); \
    GAPB(o[1]=__builtin_amdgcn_mfma_f32_32x32x16_bf16(PAF(0),VFR(4),o[1],0,0,0), C0,4,w0_); \
    KRD(GL,0); GAPB(o[0]=__builtin_amdgcn_mfma_f32_32x32x16_bf16(PAF(1),VFR(1),o[0],0,0,0), C0,8,w0_); \
    KRD(GL,1); GAPB(o[1]=__builtin_amdgcn_mfma_f32_32x32x16_bf16(PAF(1),VFR(5),o[1],0,0,0), C0,12,w0_); \
    KRD(GL,2); GAPB(o[0]=__builtin_amdgcn_mfma_f32_32x32x16_bf16(PAF(2),VFR(2),o[0],0,0,0), C1,0,w1_); \
    KRD(GL,3); GAPB(o[1]=__builtin_amdgcn_mfma_f32_32x32x16_bf16(PAF(2),VFR(6),o[1],0,0,0), C1,4,w1_); \
    GAPB(o[0]=__builtin_amdgcn_mfma_f32_32x32x16_bf16(PAF(3),VFR(3),o[0],0,0,0), C1,8,w1_); \
    GAPB(o[1]=__builtin_amdgcn_mfma_f32_32x32x16_bf16(PAF(3),VFR(7),o[1],0,0,0), C1,12,w1_); \
    }while(0)
  int t=1;
  #undef CMASK
  #define CMASK(P0,P1,t) do{}while(0)
  for(;t+5<NT;t+=2){
    STEP(pB0,pB1,pA0,pA1,t,true,true,true,true);     WAIT_BAR(2); RESC(); ROT();
    STEP(pA0,pA1,pB0,pB1,t+1,true,true,true,true);   WAIT_BAR(2); RESC(); ROT();
  }
  #undef CMASK
  #define CMASK(P0,P1,t) do{int jb_=(t)-(NT-4); if(jb_>(wid>>1)){_Pragma("unroll") for(int r_=0;r_<16;++r_){P0[r_]=-INFINITY;P1[r_]=-INFINITY;}}}while(0)
  #define ENDW(tt) do{ if((tt)+3<NT){WAIT_BAR(2);} else if((tt)+2<NT){WAIT_BAR(1);} else {WAIT_BAR(0);} }while(0)
  for(;t+1<NT;t+=2){
    STEP(pB0,pB1,pA0,pA1,t,(t+3<NT),(t+1<NT),(t+1<NT),(t+1<NT));       ENDW(t);   RESC(); ROT();
    STEP(pA0,pA1,pB0,pB1,t+1,(t+4<NT),(t+2<NT),(t+2<NT),(t+2<NT));     ENDW(t+1); RESC(); ROT();
  }
  STEP(pB0,pB1,pA0,pA1,NT-1,false,false,false,false); RESC();
  { float sacc=pB0[0]+pB0[1]; _Pragma("unroll") for(int r=2;r<16;++r)sacc+=pB0[r]; _Pragma("unroll") for(int r=0;r<16;++r)sacc+=pB1[r]; l_reg+=sacc;
    pw0=(u32x4){PKW(pB0,0),PKW(pB0,2),PKW(pB0,4),PKW(pB0,6)};pw1=(u32x4){PKW(pB0,8),PKW(pB0,10),PKW(pB0,12),PKW(pB0,14)};pw2=(u32x4){PKW(pB1,0),PKW(pB1,2),PKW(pB1,4),PKW(pB1,6)};pw3=(u32x4){PKW(pB1,8),PKW(pB1,10),PKW(pB1,12),PKW(pB1,14)};
    SBAR(); pv(o,vb0+sl_cur,PAF(0),PAF(1),PAF(2),PAF(3)); }
  #undef PKW
  #undef PAF
  #undef VFR
  #undef PIN
  #undef MX3
  #undef GAPA
  #undef GAPB
  #undef EX
  #undef VRD
  #undef KRD
  #undef STEP
  #undef ENDW
  {auto rr=__builtin_amdgcn_permlane32_swap(__float_as_uint(l_reg),__float_as_uint(l_reg),false,false);l_reg=__uint_as_float(rr[0])+__uint_as_float(rr[1]);}
  if(hi==0)wsf[32+r32]=l_reg;asm volatile("s_waitcnt lgkmcnt(0)":::"memory");
  float rli[16];
  #pragma unroll
  for(int r=0;r<16;++r)rli[r]=__builtin_amdgcn_rcpf(wsf[32+crow(r,hi)]);
  _Float16*Ow=O+(rowbase+q0+wid*QBLK)*OPITCH+h*D;
  { _Float16*stg=(_Float16*)(shm+LDS_OST)+wid*2048;
    #pragma unroll
    for(int r=0;r<16;++r){const int orow=crow(r,hi);
      #pragma unroll
      for(int d0=0;d0<2;++d0)stg[orow*64+d0*32+r32]=(_Float16)(o[d0][r]*rli[r]);}
    asm volatile("s_waitcnt lgkmcnt(0)":::"memory");
    #pragma unroll
    for(int i=0;i<4;++i){const int row=i*8+(lane>>3),ch=lane&7; const u32x4 v=*(const u32x4*)(stg+row*64+ch*8); ATTN_STORE16(Ow+(long)row*OPITCH+ch*8,v);
      typedef _Float16 h8_t __attribute__((ext_vector_type(8))); const h8_t hv=__builtin_bit_cast(h8_t,v); float ss=0.f;
      #pragma unroll
      for(int k=0;k<8;++k){const float f=(float)hv[k]; ss+=f*f;}
      ss+=__shfl_xor(ss,1); ss+=__shfl_xor(ss,2); ss+=__shfl_xor(ss,4);
      if(ch==0)SSQ[(size_t)(rowbase+q0+wid*QBLK+row)*8+h]=ss; } }
  asm volatile("s_waitcnt lgkmcnt(0)\n\ts_barrier":::"memory");
  #undef DMA_K
  #undef DMA_V
  #undef CMASK
  #undef START
  #undef RESC
  #undef ROT
  #undef MLOAD
  #undef MWORDS
  #undef MBIT
  #undef MAND
  #undef MAND0
}
constexpr int ATTN_LDS_BYTES=LDS_BYTES;
struct AttnTensors { const bf16* Q; const bf16* K; const bf16* V; _Float16* O; const unsigned* MASKP; float* SSQ; };
struct AttnUnit { int bh; int qb; };
struct StaticOrder {
  int vcu,G;
  __device__ __forceinline__ explicit StaticOrder(int grid,int block):vcu((grid%8==0)?(block%8)*(grid/8)+block/8:block),G(grid){}
  __device__ __forceinline__ bool next(int i,AttnUnit&u)const{
    if(G==256){ if(i>=8)return false; const int s=vcu&3; u.bh=vcu>>2; const int base=(i>>1)*8; u.qb=(i&1)?base+7-s:base+s; return true; }
    const int L=i*G+vcu; if(L>=BATCH*NHEAD*NQB)return false; u.bh=L/NQB; u.qb=L%NQB; return true; }
};
template<class Sched,int THRL=8> __device__ __forceinline__ void attn_phase(char*lds,const AttnTensors&T,const Sched&S){
  AttnUnit u;
  for(int i=0;S.next(i,u);++i){ attn_unit<THRL>(u.bh/NHEAD,u.bh%NHEAD,u.qb,T.Q,T.K,T.V,T.O,T.MASKP,T.SSQ,lds); }
}
#undef SBAR
#undef WAIT_BAR
}


#ifndef PROBE_DUP
#define PROBE_DUP -1
#endif
#ifndef IDX_STAGGER
#define IDX_STAGGER 6
#endif
#define LDS_WAIT() asm volatile("s_waitcnt lgkmcnt(0)" ::: "memory")

__device__ __forceinline__ void mod_phase(LAS unsigned char* lds, const float* c, const float* w_ada, const float* b_ada, float* mod, int tid, int G) {
    LAS float* sl = (LAS float*)(lds + 69632);
    LAS float* red = (LAS float*)(lds + 102400);
    if ((int)blockIdx.x >= 96) return;
    for (int i = tid; i < 8192; i += 512) { const float v = c[i]; sl[i] = v / (1.f + __expf(-v)); }
    __syncthreads();
    for (int u = blockIdx.x; u < 96; u += G) {
        const int col = u * 64 + (tid & 63), ks = tid >> 6;
        float acc[8];
#pragma unroll
        for (int b = 0; b < 8; ++b) acc[b] = 0.f;
        for (int k = ks * 128; k < ks * 128 + 128; ++k) {
            const float w = w_ada[(size_t)k * 6144 + col];
#pragma unroll
            for (int b = 0; b < 8; ++b) acc[b] += sl[b * 1024 + k] * w;
        }
#pragma unroll
        for (int b = 0; b < 8; ++b) red[(ks * 8 + b) * 64 + (tid & 63)] = acc[b];
        __syncthreads();
        { const int b = tid >> 6, cx = tid & 63; float s = 0.f;
#pragma unroll
          for (int k2 = 0; k2 < 8; ++k2) s += red[(k2 * 8 + b) * 64 + cx];
          mod[b * 6144 + u * 64 + cx] = s + b_ada[u * 64 + cx]; }
        __syncthreads();
    }
}

template <class SrcCol, class KScale>
__device__ __forceinline__ void transpose_item(const float* W, int ldw, int kxor, h16* WT, int ldt, int destrow0, int k0, SrcCol sc, KScale ks, LAS float* scr, int lane) {
    const int n = lane & 31; const int col = sc(destrow0 + n);
#pragma unroll 8
    for (int i = 0; i < 32; ++i) { const int kk = 2 * i + (lane >> 5); const int sk = (k0 + kk) ^ kxor; float v = 0.f; if (col >= 0) v = W[(size_t)sk * ldw + col] * ks(sk); scr[kk * 33 + n] = v; }
    LDS_WAIT(); asm volatile("" ::: "memory");
    const int c = lane & 7;
#pragma unroll
    for (int j = 0; j < 4; ++j) { const int nn = (lane >> 3) + 8 * j; const LAS float* s = scr + (8 * c) * 33 + nn;
        u32x4 o; o.x = pkh(s[0 * 33], s[1 * 33]); o.y = pkh(s[2 * 33], s[3 * 33]); o.z = pkh(s[4 * 33], s[5 * 33]); o.w = pkh(s[6 * 33], s[7 * 33]);
        *(u32x4*)(WT + (size_t)(destrow0 + nn) * ldt + k0 + 8 * c) = o; }
    LDS_WAIT(); asm volatile("" ::: "memory");
}
template <class SrcCol>
__device__ __forceinline__ void transpose_item_f8(const float* W, int ldw, unsigned char* WT, int ldt, int destrow0, int k0, SrcCol sc, float scale, LAS float* scr, int lane) {
    const int n = lane & 31; const int col = sc(destrow0 + n);
#pragma unroll 8
    for (int i = 0; i < 32; ++i) { const int kk = 2 * i + (lane >> 5); scr[kk * 33 + n] = W[(size_t)(k0 + kk) * ldw + col] * scale; }
    LDS_WAIT(); asm volatile("" ::: "memory");
    const int c = lane & 7;
#pragma unroll
    for (int j = 0; j < 4; ++j) { const int nn = (lane >> 3) + 8 * j; const LAS float* s = scr + (8 * c) * 33 + nn;
        u32x2 o; o.x = pk4f8(s[0 * 33], s[1 * 33], s[2 * 33], s[3 * 33]); o.y = pk4f8(s[4 * 33], s[5 * 33], s[6 * 33], s[7 * 33]);
        *(u32x2*)(WT + (size_t)(destrow0 + nn) * ldt + k0 + 8 * c) = o; }
    LDS_WAIT(); asm volatile("" ::: "memory");
}
__device__ __forceinline__ int win_src(int dr) {
    const int pn = dr >> 8, tc = dr & 255, w = tc & 31, wc = (tc >> 5) & 3, bj = tc >> 7;
    if (pn < 4) return pn * 256 + tc;
    if (pn < 8) return (pn < 6 ? 1024 : 1536) + ((pn & 1) * 4 + wc) * 64 + bj * 32 + w;
    if (pn < 12) return 2048 + (pn - 8) * 256 + tc;
    if (wc == 0) return 3072 + bj * 32 + w;
    if (wc == 1 && bj == 0 && w < 8) return 3136 + w;
    return -1;
}
__device__ __forceinline__ void transpose_item_w1(const float* W, unsigned char* WT, int f0, int k0, float scale, LAS float* scr, int lane) {
    const int n = lane & 31;
    f32x2 v[32];
#pragma unroll
    for (int i = 0; i < 32; ++i) { const int kk = 2 * i + (lane >> 5); v[i] = *(const f32x2*)(W + (size_t)(k0 + kk) * 2048 + 2 * (f0 + n)); }
    const int drow = 256 * (f0 >> 7) + (f0 & 127);
#pragma unroll
    for (int par = 0; par < 2; ++par) {
#pragma unroll
        for (int i = 0; i < 32; ++i) { const int kk = 2 * i + (lane >> 5); scr[kk * 33 + n] = v[i][par] * scale; }
        LDS_WAIT(); asm volatile("" ::: "memory");
        const int c = lane & 7;
#pragma unroll
        for (int j = 0; j < 4; ++j) { const int nn = (lane >> 3) + 8 * j; const LAS float* s = scr + (8 * c) * 33 + nn;
            u32x2 o; o.x = pk4f8(s[0 * 33], s[1 * 33], s[2 * 33], s[3 * 33]); o.y = pk4f8(s[4 * 33], s[5 * 33], s[6 * 33], s[7 * 33]);
            *(u32x2*)(WT + (size_t)(drow + 128 * par + nn) * 1024 + k0 + 8 * c) = o; }
        LDS_WAIT(); asm volatile("" ::: "memory");
    }
}
struct P0Args { const float *w_in, *w_out, *rg_g, *at_g, *w1, *w2, *w_router, *w_rg_a, *w_rg_x; h16 *WIN, *WOUT; unsigned char *W1, *W2; h16 *WROUT, *WRG; };
__device__ __forceinline__ void convert_phase(LAS unsigned char* lds, const P0Args& a, int tid, int lane, int wave, int gw, int NGW) {
    LAS float* scr = (LAS float*)(lds + wave * 8448);
    constexpr int I_IN = 104 * 16, I_OUT = 32 * 16, I_1 = 32 * 32 * 16, I_2 = 32 * 32 * 16, I_R = 16;
    constexpr int NITEMS = I_IN + I_OUT + I_1 + I_2 + I_R;
    auto one = [](int) { return 1.f; };
    for (int it = gw; it < NITEMS; it += NGW) {
        int r = it;
        if (r < I_IN) { transpose_item(a.w_in, DIN, 0, a.WIN, 1024, (r >> 4) * 32, (r & 15) * 64, [](int dr) { return win_src(dr); }, one, scr, lane); continue; } r -= I_IN;
        if (r < I_OUT) { const float* rg = a.rg_g; const float* ag = a.at_g;
            transpose_item(a.w_out, 1024, 512, a.WOUT, 1024, (r >> 4) * 32, (r & 15) * 64, [](int dr) { return dr; }, [rg, ag](int sk) { return sk < 512 ? rg[sk] : ag[sk - 512]; }, scr, lane); continue; } r -= I_OUT;
        if (r < I_1) { const int e = r >> 9, q = r & 511;
            transpose_item_w1(a.w1 + (size_t)e * 1024 * 2048, a.W1 + (size_t)e * 2048 * 1024, (q >> 4) * 32, (q & 15) * 64, W1_F8_SCALE, scr, lane); continue; } r -= I_1;
        if (r < I_2) { const int e = r >> 9, q = r & 511;
            transpose_item_f8(a.w2 + (size_t)e * 1024 * 1024, 1024, a.W2 + (size_t)e * 1024 * 1024, 1024, (q >> 4) * 32, (q & 15) * 64, [](int dr) { return dr; }, W2_F8_SCALE, scr, lane); continue; } r -= I_2;
        transpose_item(a.w_router, 32, 0, a.WROUT, 1024, (r >> 4) * 32, (r & 15) * 64, [](int dr) { return dr < 32 ? dr : -1; }, one, scr, lane);
    }
    if ((int)blockIdx.x < 8) {
        const int hb = blockIdx.x;
        for (int i = tid; i < 128 * 64; i += 512) { const int rr = i >> 6, k = i & 63, p = rr >> 5, gate = (rr >> 4) & 1, cc = rr & 15;
            const float* src = gate ? a.w_rg_x : a.w_rg_a; a.WRG[(size_t)hb * 8192 + i] = (h16)src[(size_t)hb * 4096 + k * 64 + 16 * p + cc]; }
    }
}

__device__ __forceinline__ void rmsnorm_rows(const float* src, h16* dst, unsigned char* dst8, const float* gain, const float* sc, const float* sh, int gw, int NGW, int lane) {
    for (int chunk = gw; chunk < T / 32; chunk += NGW) {
        const int row0 = chunk * 32, b = row0 >> 13;
        f32x4 scale[4], shift[4];
#pragma unroll
        for (int j = 0; j < 4; ++j) { const int k = 4 * lane + 256 * j; const f32x4 g = *(const f32x4*)(gain + k), s1 = *(const f32x4*)(sc + b * 6144 + k); scale[j] = g * (1.f + s1); shift[j] = *(const f32x4*)(sh + b * 6144 + k); }
        for (int r = 0; r < 32; ++r) {
            const size_t ro = (size_t)(row0 + r) * 1024 + 4 * lane;
            f32x4 v[4]; float ss = 0.f;
#pragma unroll
            for (int j = 0; j < 4; ++j) { v[j] = *(const f32x4*)(src + ro + 256 * j); ss += (v[j][0] * v[j][0] + v[j][1] * v[j][1]) + (v[j][2] * v[j][2] + v[j][3] * v[j][3]); }
            const float rs = rsqrtf(wave_sum(ss) * (1.f / 1024.f) + EPS);
#pragma unroll
            for (int j = 0; j < 4; ++j) { const f32x4 y = v[j] * rs * scale[j] + shift[j]; u32x2 o; o.x = pkh(y[0], y[1]); o.y = pkh(y[2], y[3]); *(u32x2*)(dst + ro + 256 * j) = o;
                if (dst8) *(unsigned*)(dst8 + ro + 256 * j) = pk4f8(y[0], y[1], y[2], y[3]); }
        }
    }
}

__device__ __forceinline__ void rg_phase(LAS unsigned char* lds, const h16* XR, const float* conv_w, const float* conv_b, const h16* WRG, const float* b_a, const float* b_x, const float* lam,
                                         h16* HL, h16* AC, float* SUMP, float* SUMH, int tid, int lane, int wave, int G) {
    constexpr int XCS = 520;
    LAS h16* xc = (LAS h16*)lds;
    LAS h16* stg = (LAS h16*)(lds + 66560) + wave * 2048;
    const int cl = lane & 15, q = lane >> 4;
    if ((int)blockIdx.x >= 1024) return;
    f16x8 Bg[8][2];
#pragma unroll
    for (int nt = 0; nt < 8; ++nt)
#pragma unroll
        for (int ks = 0; ks < 2; ++ks) Bg[nt][ks] = *(const f16x8*)(WRG + ((size_t)(wave * 128 + nt * 16 + cl) * 64 + ks * 32 + q * 8));
    float ba[4], bx[4], sp[4];
#pragma unroll
    for (int p = 0; p < 4; ++p) { const int ch = wave * 64 + 16 * p + cl; ba[p] = b_a[ch]; bx[p] = b_x[ch]; const float nl = -lam[ch]; sp[p] = nl > 20.f ? nl : log1pf(__expf(nl)); }
    const int co = tid & 63;
    float cw[4][8], cb[8];
#pragma unroll
    for (int j = 0; j < 4; ++j) { const f32x4 a0 = *(const f32x4*)(conv_w + j * 512 + 8 * co), a1 = *(const f32x4*)(conv_w + j * 512 + 8 * co + 4);
#pragma unroll
        for (int k = 0; k < 4; ++k) { cw[j][k] = a0[k]; cw[j][4 + k] = a1[k]; } }
    { const f32x4 a0 = *(const f32x4*)(conv_b + 8 * co), a1 = *(const f32x4*)(conv_b + 8 * co + 4);
#pragma unroll
      for (int k = 0; k < 4; ++k) { cb[k] = a0[k]; cb[4 + k] = a1[k]; } }
    for (int u = blockIdx.x; u < 1024; u += G) {
        const int b = u >> 7, chn = u & 127, s0 = chn * 64; const size_t t0 = (size_t)b * 8192 + s0;
        {
            f16x8 xin[11];
#pragma unroll
            for (int i = 0; i < 11; ++i) { const int s = s0 + 8 * wave - 3 + i; f16x8 z = {0, 0, 0, 0, 0, 0, 0, 0}; xin[i] = (s >= 0) ? *(const f16x8*)(XR + ((size_t)b * 8192 + s) * 512 + 8 * co) : z; }
#pragma unroll
            for (int i = 0; i < 8; ++i) {
                float o[8];
#pragma unroll
                for (int k = 0; k < 8; ++k) { float a = cb[k];
#pragma unroll
                    for (int j = 0; j < 4; ++j) a += cw[j][k] * (float)xin[i + j][k];
                    o[k] = a; }
                u32x4 w; w.x = pkh(o[0], o[1]); w.y = pkh(o[2], o[3]); w.z = pkh(o[4], o[5]); w.w = pkh(o[6], o[7]);
                *(LAS u32x4*)(xc + (8 * wave + i) * XCS + 8 * co) = w;
            }
        }
        __syncthreads();
        float Pm[4], Hm[4];
#pragma unroll
        for (int p = 0; p < 4; ++p) { Pm[p] = 1.f; Hm[p] = 0.f; }
#pragma unroll 1
        for (int mt = 0; mt < 4; ++mt) {
            f16x8 Af[2];
#pragma unroll
            for (int ks = 0; ks < 2; ++ks) Af[ks] = *(const LAS f16x8*)(xc + (mt * 16 + cl) * XCS + wave * 64 + ks * 32 + q * 8);
#pragma unroll
            for (int p = 0; p < 4; ++p) {
                f32x4 ca = {0.f, 0.f, 0.f, 0.f}, cx = {0.f, 0.f, 0.f, 0.f};
#pragma unroll
                for (int ks = 0; ks < 2; ++ks) { ca = __builtin_amdgcn_mfma_f32_16x16x32_f16(Af[ks], Bg[2 * p][ks], ca, 0, 0, 0); cx = __builtin_amdgcn_mfma_f32_16x16x32_f16(Af[ks], Bg[2 * p + 1][ks], cx, 0, 0, 0); }
                float a[4], uu[4];
#pragma unroll
                for (int j = 0; j < 4; ++j) {
                    const float xcv = (float)xc[(mt * 16 + 4 * q + j) * XCS + wave * 64 + 16 * p + cl];
                    const float ra = sigmoidf_(ca[j] + ba[p]), ix = sigmoidf_(cx[j] + bx[p]);
                    const float la = -8.f * ra * sp[p];
                    a[j] = __expf(la);
                    const float x2 = 2.f * la, ser = -x2 * __builtin_fmaf(x2, __builtin_fmaf(x2, __builtin_fmaf(x2, 1.f / 24.f, 1.f / 6.f), 0.5f), 1.f);
                    const float om = x2 > -0.125f ? ser : __builtin_fmaf(-a[j], a[j], 1.f);
                    uu[j] = __builtin_amdgcn_sqrtf(fmaxf(om, 0.f)) * ix * xcv;
                }
                float iA = a[0] * a[1] * a[2] * a[3], iH = ((uu[0] * a[1] + uu[1]) * a[2] + uu[2]) * a[3] + uu[3];
                float tA = __shfl_up(iA, 16), tH = __shfl_up(iH, 16); if (q >= 1) { iH = iA * tH + iH; iA = tA * iA; }
                tA = __shfl_up(iA, 32); tH = __shfl_up(iH, 32); if (q >= 2) { iH = iA * tH + iH; iA = tA * iA; }
                float eA = __shfl_up(iA, 16), eH = __shfl_up(iH, 16); if (q == 0) { eA = 1.f; eH = 0.f; }
                const float totA = __shfl(iA, 48 + cl), totH = __shfl(iH, 48 + cl);
                float Pg = Pm[p] * eA, Hg = eA * Hm[p] + eH;
#pragma unroll
                for (int j = 0; j < 4; ++j) { Hg = a[j] * Hg + uu[j]; Pg *= a[j]; stg[(4 * q + j) * 64 + 16 * p + cl] = (h16)Hg; stg[1024 + (4 * q + j) * 64 + 16 * p + cl] = (h16)Pg; }
                Hm[p] = totA * Hm[p] + totH; Pm[p] = Pm[p] * totA;
            }
            LDS_WAIT(); asm volatile("" ::: "memory");
#pragma unroll
            for (int it = 0; it < 2; ++it) { const int idx = lane + 64 * it, r = idx >> 3, c8 = idx & 7; const size_t go = (t0 + mt * 16 + r) * 512 + wave * 64 + c8 * 8;
                *(u32x4*)(HL + go) = *(const LAS u32x4*)(stg + r * 64 + c8 * 8); *(u32x4*)(AC + go) = *(const LAS u32x4*)(stg + 1024 + r * 64 + c8 * 8); }
            LDS_WAIT(); asm volatile("" ::: "memory");
        }
        if (q == 0) {
#pragma unroll
            for (int p = 0; p < 4; ++p) { const size_t so = ((size_t)b * 128 + chn) * 512 + wave * 64 + 16 * p + cl; SUMP[so] = Pm[p]; SUMH[so] = Hm[p]; }
        }
        __syncthreads();
    }
}

__device__ __forceinline__ void r3_phase(LAS unsigned char* lds, const h16* HL, const h16* AC, const h16* XG, const float* SUMP, const float* SUMH, h16* MIX, int tid, int lane, int wave, int G) {
    LAS float* carry = (LAS float*)lds;
    for (int u = blockIdx.x; u < 1024; u += G) {
        const int b = u >> 7, chn = u & 127;
        { float cr = 0.f; const float* sp = SUMP + (size_t)b * 128 * 512 + tid; const float* sh = SUMH + (size_t)b * 128 * 512 + tid;
          int c2 = 0;
          for (; c2 + 8 <= chn; c2 += 8) { float pv[8], hv[8];
#pragma unroll
              for (int k = 0; k < 8; ++k) { pv[k] = sp[(size_t)(c2 + k) * 512]; hv[k] = sh[(size_t)(c2 + k) * 512]; }
#pragma unroll
              for (int k = 0; k < 8; ++k) cr = pv[k] * cr + hv[k]; }
          for (; c2 < chn; ++c2) cr = sp[(size_t)c2 * 512] * cr + sh[(size_t)c2 * 512];
          carry[tid] = cr; }
        __syncthreads();
        const f32x4 c0 = *(const LAS f32x4*)(carry + 8 * lane), c1 = *(const LAS f32x4*)(carry + 8 * lane + 4);
        float cv[8] = {c0[0], c0[1], c0[2], c0[3], c1[0], c1[1], c1[2], c1[3]};
#pragma unroll 2
        for (int i = 0; i < 8; ++i) {
            const size_t t = (size_t)b * 8192 + chn * 64 + wave * 8 + i; const size_t off = t * 512 + 8 * lane;
            const f16x8 hl = *(const f16x8*)(HL + off), ac = *(const f16x8*)(AC + off), xg = *(const f16x8*)(XG + off);
            float y[8], ss = 0.f;
#pragma unroll
            for (int k = 0; k < 8; ++k) { const float x = (float)xg[k]; const float z = 0.7978845608028654f * (x + 0.044715f * x * x * x); const float th = 1.f - 2.f / (__expf(2.f * z) + 1.f);
                y[k] = 0.5f * x * (1.f + th) * ((float)hl[k] + (float)ac[k] * cv[k]); ss += y[k] * y[k]; }
            const float rs = rsqrtf(wave_sum(ss) * (1.f / 512.f) + EPS);
            u32x4 w; w.x = pkh(y[0] * rs, y[1] * rs); w.y = pkh(y[2] * rs, y[3] * rs); w.z = pkh(y[4] * rs, y[5] * rs); w.w = pkh(y[6] * rs, y[7] * rs);
            *(u32x4*)(MIX + t * 1024 + 512 + 8 * lane) = w;
        }
        __syncthreads();
    }
}

__device__ __forceinline__ int idx_bin(float sc) {
    const unsigned u = __float_as_uint(sc);
    int v = (int)((u << 1) >> 20) - (114 << 4);
    v = v < 0 ? 0 : (v > 255 ? 255 : v);
    const unsigned sg = (unsigned)((int)u >> 31);
    return (int)((unsigned)v ^ 0x100u ^ (sg & 0x1ffu));
}
__device__ __forceinline__ float idx_edge(int b) {
    if (b >= 512) return INFINITY;
    if (b <= 0) return -INFINITY;
    if (b >= 256) { const int v = b - 256; return v == 0 ? 0.f : __uint_as_float((unsigned)(v + 1824) << 19); }
    const int v = 255 - b; return -__uint_as_float(((unsigned)(v + 1825) << 19) - 1u);
}
__device__ __forceinline__ float fma_np(float a, float b, float c) { float r; asm("v_fma_f32 %0, %1, %2, %3" : "=v"(r) : "v"(a), "v"(b), "v"(c)); return r; }
__device__ __forceinline__ float relu_i(float x) { const int i = __float_as_int(x); return __int_as_float(i > 0 ? i : 0); }
__device__ __forceinline__ void idx_glds16(const void* gsrc, unsigned lds_dst) { unsigned keep;
    asm volatile("s_mov_b32 %0, m0\n\ts_mov_b32 m0, %2\n\ts_nop 0\n\tglobal_load_lds_dwordx4 %1, off\n\ts_mov_b32 m0, %0" : "=&s"(keep) : "v"(gsrc), "s"(lds_dst) : "memory"); }
__device__ __forceinline__ float fma_wlo(float a, unsigned w, float c) { float r; asm("v_fma_mix_f32 %0, %1, %2, %3 op_sel:[0,0,0] op_sel_hi:[0,1,0]" : "=v"(r) : "v"(a), "v"(w), "v"(c)); return r; }
__device__ __forceinline__ float fma_whi(float a, unsigned w, float c) { float r; asm("v_fma_mix_f32 %0, %1, %2, %3 op_sel:[0,1,0] op_sel_hi:[0,1,0]" : "=v"(r) : "v"(a), "v"(w), "v"(c)); return r; }
__device__ __forceinline__ unsigned idx_binoff(float sc) {
    const int u = __float_as_int(sc);
    int v = (int)__builtin_amdgcn_ubfe((unsigned)u, 19, 12) - (114 << 4);
    v = v < 0 ? 0 : (v > 255 ? 255 : v);
    return (unsigned)(v ^ ((u >> 31) & 0x1ff) ^ 0x100) << 2;
}
__device__ __forceinline__ void idx_phase(LAS unsigned char* lds, const h16* QI, const h16* KI, const float* WI, unsigned* MASK, int tid, int lane, int wave, int G) {
    LAS unsigned* hist = (LAS unsigned*)lds;
    LAS unsigned* maskq = (LAS unsigned*)(lds + 65536);
    LAS int* bstar = (LAS int*)(lds + 131072); LAS int* cabove = bstar + 32; LAS unsigned* ccount = (LAS unsigned*)(bstar + 64);
    LAS float* wtab = (LAS float*)(lds + 131072 + 512);
    LAS float* thr = (LAS float*)(lds + 131072 + 1536);
    const int qh = wave >> 2, kq = wave & 3, n32 = lane & 31, half = lane >> 5;
    for (int U = blockIdx.x; U < 2048; U += G) {
        const int b = U >> 8, cc = U & 255, ub = (b & 1) ? 255 - cc : cc;
        const size_t t0 = (size_t)b * 8192 + ub * 32; const int nadm = 64 * ((ub >> 1) + 1), nkt = nadm >> 5;
        if (nadm <= TOPK) {
            for (int i = tid; i < 32 * nkt; i += 512) { const int tok = i / nkt, kt = i % nkt; MASK[(t0 + tok) * 256 + kt] = 0xffffffffu; }
            continue;
        }
#pragma unroll
        for (int i = 0; i < 8; ++i) ((LAS u32x4*)hist)[tid + 512 * i] = (u32x4){0u, 0u, 0u, 0u};
        if (tid < 32) ccount[tid] = 0u;
        if (tid < 256) wtab[tid] = WI[t0 * 8 + tid] * IDX_WSCALE;
        f16x8 Aq[4][4];
        { const int r = lane & 31, tt = 2 * (r >> 4) + ((r >> 2) & 1), hd = (r & 3) + 4 * ((r >> 3) & 1);
#pragma unroll
          for (int j = 0; j < 4; ++j)
#pragma unroll
              for (int s = 0; s < 4; ++s) Aq[j][s] = *(const f16x8*)(QI + (t0 + 16 * qh + 4 * j + tt) * 512 + hd * 64 + 16 * s + 8 * half);
        }
#pragma unroll
        for (int j = 0; j < 4; ++j)
#pragma unroll
            for (int s2 = 0; s2 < 4; ++s2) asm volatile("" : "+v"(Aq[j][s2]));
        asm volatile("s_waitcnt vmcnt(0)" ::: "memory");
        __syncthreads();
        const h16* kp = KI + (size_t)b * 8192 * 64 + n32 * 64 + 8 * half;
        const int tokl0 = 16 * qh + half;
        unsigned W16[8][4];
#pragma unroll
        for (int ii = 0; ii < 8; ++ii) { const LAS f32x4* wp_ = (const LAS f32x4*)(wtab + (tokl0 + 2 * ii) * 8); const f32x4 w0 = wp_[0], w1 = wp_[1];
            W16[ii][0] = pkh(w0[0], w0[1]); W16[ii][1] = pkh(w0[2], w0[3]); W16[ii][2] = pkh(w1[0], w1[1]); W16[ii][3] = pkh(w1[2], w1[3]); }
        const f32x16 zero16 = {0.f, 0.f, 0.f, 0.f, 0.f, 0.f, 0.f, 0.f, 0.f, 0.f, 0.f, 0.f, 0.f, 0.f, 0.f, 0.f};
        const int ktl = kq + 4 * ((nkt - 1 - kq) >> 2);
#define IDX_LOADB(DST, KT) do { _Pragma("unroll") for (int s2 = 0; s2 < 4; ++s2) DST[s2] = *(const f16x8*)(kp + (size_t)((KT) <= ktl ? (KT) : ktl) * 2048 + 16 * s2); } while (0)
#define IDX_SB __builtin_amdgcn_sched_barrier(0)
#define IDX_MF(ACC, J, K, BK_) ACC = __builtin_amdgcn_mfma_f32_32x32x16_f16(Aq[J][K], BK_[K], (K) == 0 ? zero16 : ACC, 0, 0, 0)
#define IDX_Q(ACC, II, BP, HF) do { s0 = fma_wlo(relu_i(ACC[8 * (BP) + 4 * (HF) + 0]), W16[II][2 * (HF)], s0); s1 = fma_whi(relu_i(ACC[8 * (BP) + 4 * (HF) + 1]), W16[II][2 * (HF)], s1); \
        s0 = fma_wlo(relu_i(ACC[8 * (BP) + 4 * (HF) + 2]), W16[II][2 * (HF) + 1], s0); s1 = fma_whi(relu_i(ACC[8 * (BP) + 4 * (HF) + 3]), W16[II][2 * (HF) + 1], s1); } while (0)
#define IDX_STEP(CUR, J, NXT, JN, BN_) do { float s0 = 0.f, s1 = 0.f; \
        IDX_MF(NXT, JN, 0, BN_); IDX_SB; IDX_Q(CUR, 2 * (J), 0, 0); IDX_SB; IDX_MF(NXT, JN, 1, BN_); IDX_SB; \
        IDX_Q(CUR, 2 * (J), 0, 1); sc[2 * (J)] = s0 + s1; s0 = 0.f; s1 = 0.f; IDX_SB; IDX_MF(NXT, JN, 2, BN_); IDX_SB; \
        IDX_Q(CUR, 2 * (J) + 1, 1, 0); IDX_SB; IDX_MF(NXT, JN, 3, BN_); IDX_SB; \
        IDX_Q(CUR, 2 * (J) + 1, 1, 1); sc[2 * (J) + 1] = s0 + s1; IDX_SB; } while (0)
#define IDX_TILE(KT_, BC_, BN_) do { IDX_STEP(accA, 0, accB, 1, BC_); IDX_STEP(accB, 1, accA, 2, BC_); IDX_STEP(accA, 2, accB, 3, BC_); IDX_STEP(accB, 3, accA, 0, BN_); IDX_LOADB(BC_, (KT_) + 8); } while (0)
        f16x8 B0[4], B1[4];
        {
            IDX_LOADB(B0, kq); IDX_LOADB(B1, kq + 4);
            if (wave >= 4) __builtin_amdgcn_s_sleep(IDX_STAGGER);
            f32x16 accA, accB;
            IDX_MF(accA, 0, 0, B0); IDX_MF(accA, 0, 1, B0); IDX_MF(accA, 0, 2, B0); IDX_MF(accA, 0, 3, B0);
            LAS unsigned char* hb = (LAS unsigned char*)hist + tokl0 * 2048;
#define IDX_HIST() do { _Pragma("unroll") for (int q = 0; q < 8; ++q) \
        __hip_atomic_fetch_add((LAS unsigned*)(hb + 4096 * q + idx_binoff(sc[q])), 1u, __ATOMIC_RELAXED, __HIP_MEMORY_SCOPE_WORKGROUP); } while (0)
#pragma unroll 1
            for (int kt = kq; kt < nkt; kt += 8) {
                float sc[8];
                IDX_TILE(kt, B0, B1); IDX_HIST();
                if (kt + 4 >= nkt) break;
                IDX_TILE(kt + 4, B1, B0); IDX_HIST();
            }
            asm volatile("" :: "v"(accA));
#undef IDX_HIST
        }
        __syncthreads();
        {
            const int tok = tid >> 4, sub = tid & 15; const LAS unsigned* hrow = hist + tok * 512;
            unsigned s = 0;
#pragma unroll
            for (int w = 0; w < 8; ++w) { const u32x4 x = *(const LAS u32x4*)(hrow + 32 * sub + 4 * w); s += (x.x + x.y) + (x.z + x.w); }
            unsigned v = s;
#pragma unroll
            for (int d = 1; d < 16; d <<= 1) { const unsigned t = __shfl_down(v, d, 16); if (sub + d < 16) v += t; }
            const unsigned above = v - s;
            if (above < (unsigned)TOPK && v >= (unsigned)TOPK) {
                unsigned cum = above;
                for (int bin = 32 * sub + 31; bin >= 32 * sub; --bin) { const unsigned c = hrow[bin];
                    if (cum + c >= (unsigned)TOPK) { bstar[tok] = bin; cabove[tok] = (int)cum; thr[2 * tok] = idx_edge(bin); thr[2 * tok + 1] = idx_edge(bin + 1); break; } cum += c; }
            }
        }
        __syncthreads();
        {
            IDX_LOADB(B0, kq); IDX_LOADB(B1, kq + 4);
            if (wave >= 4) __builtin_amdgcn_s_sleep(IDX_STAGGER);
            f32x16 accA, accB;
            IDX_MF(accA, 0, 0, B0); IDX_MF(accA, 0, 1, B0); IDX_MF(accA, 0, 2, B0); IDX_MF(accA, 0, 3, B0);
#define IDX_CLASS(KT_) do { unsigned long long anyc = 0ull; unsigned mlo = 0u, mhi = 0u; float tlo[8], thi[8]; unsigned long long bal[8]; \
        _Pragma("unroll") for (int q = 0; q < 8; ++q) { const f32x2 e_ = *(const LAS f32x2*)(thr + 2 * (tokl0 + 2 * q)); tlo[q] = e_[0]; thi[q] = e_[1]; }     \
        _Pragma("unroll") for (int q = 0; q < 8; ++q) { bal[q] = __ballot(sc[q] >= thi[q]); anyc |= __ballot(sc[q] >= tlo[q]) & ~bal[q]; } \
          \
        asm volatile("s_nop 3\n\t" "v_writelane_b32 %0, %2, 0\n\tv_writelane_b32 %0, %3, 1\n\tv_writelane_b32 %0, %4, 2\n\tv_writelane_b32 %0, %5, 3\n\tv_writelane_b32 %0, %6, 4\n\tv_writelane_b32 %0, %7, 5\n\tv_writelane_b32 %0, %8, 6\n\tv_writelane_b32 %0, %9, 7\n\t" \
                     "v_writelane_b32 %1, %10, 0\n\tv_writelane_b32 %1, %11, 1\n\tv_writelane_b32 %1, %12, 2\n\tv_writelane_b32 %1, %13, 3\n\tv_writelane_b32 %1, %14, 4\n\tv_writelane_b32 %1, %15, 5\n\tv_writelane_b32 %1, %16, 6\n\tv_writelane_b32 %1, %17, 7" \
                     : "+v"(mlo), "+v"(mhi) : "s"((unsigned)bal[0]), "s"((unsigned)bal[1]), "s"((unsigned)bal[2]), "s"((unsigned)bal[3]), "s"((unsigned)bal[4]), "s"((unsigned)bal[5]), "s"((unsigned)bal[6]), "s"((unsigned)bal[7]), \
                       "s"((unsigned)(bal[0] >> 32)), "s"((unsigned)(bal[1] >> 32)), "s"((unsigned)(bal[2] >> 32)), "s"((unsigned)(bal[3] >> 32)), "s"((unsigned)(bal[4] >> 32)), "s"((unsigned)(bal[5] >> 32)), "s"((unsigned)(bal[6] >> 32)), "s"((unsigned)(bal[7] >> 32))); \
        if (lane < 8) { maskq[(16 * qh + 2 * lane) * 256 + (KT_)] = mlo; maskq[(16 * qh + 2 * lane + 1) * 256 + (KT_)] = mhi; }     \
        if (anyc) { _Pragma("unroll") for (int q = 0; q < 8; ++q) { if (sc[q] >= tlo[q] && !(sc[q] >= thi[q])) { const int tokl = tokl0 + 2 * q; \
            const unsigned ci = __hip_atomic_fetch_add(&ccount[tokl], 1u, __ATOMIC_RELAXED, __HIP_MEMORY_SCOPE_WORKGROUP); \
            if (ci < 128u) ((LAS u32x2*)hist)[tokl * 128 + ci] = (u32x2){__float_as_uint(sc[q]), (unsigned)(32 * (KT_) + n32)}; } } } } while (0)
#pragma unroll 1
            for (int kt = kq; kt < nkt; kt += 8) {
                float sc[8];
                IDX_TILE(kt, B0, B1); IDX_CLASS(kt);
                if (kt + 4 >= nkt) break;
                IDX_TILE(kt + 4, B1, B0); IDX_CLASS(kt + 4);
            }
            asm volatile("" :: "v"(accA));
#undef IDX_CLASS
        }
        __syncthreads();
#undef IDX_TILE
#undef IDX_STEP
#undef IDX_Q
#undef IDX_MF
#undef IDX_SB
#undef IDX_LOADB
        {
            const int tok = tid >> 4, sub = tid & 15; const unsigned m0 = ccount[tok]; const int m = m0 < 128u ? (int)m0 : 128; const int r = TOPK - cabove[tok];
            const LAS u32x2* cd = (const LAS u32x2*)hist + tok * 128;
            for (int i = sub; i < m; i += 16) { const u32x2 ci = cd[i]; const float si = __uint_as_float(ci.x); int rank = 0;
                for (int j2 = 0; j2 < m; ++j2) { const u32x2 cj = cd[j2]; const float sj = __uint_as_float(cj.x); rank += (sj > si || (sj == si && cj.y < ci.y)) ? 1 : 0; }
                if (rank < r) __hip_atomic_fetch_or(&maskq[tok * 256 + (ci.y >> 5)], 1u << (ci.y & 31u), __ATOMIC_RELAXED, __HIP_MEMORY_SCOPE_WORKGROUP); }
        }
        __syncthreads();
        for (int i = tid; i < 32 * nkt; i += 512) { const int tok = i / nkt, kt = i % nkt; MASK[(t0 + tok) * 256 + kt] = maskq[tok * 256 + kt]; }
        asm volatile("s_waitcnt vmcnt(0)" ::: "memory");
        __syncthreads();
    }
}

__device__ __forceinline__ void norm_route_phase(LAS unsigned char* lds, const float* x1, unsigned char* H8, const float* gain, const float* sc, const float* sh,
        const h16* WR, const float* b_router, unsigned* CNT, u64* ROWINFO, unsigned* TOKSLOT, int tid, int lane, int wave, int G, int vcu) {
    constexpr int WPITCH = 2064;
    LAS unsigned char* wl = lds;
    LAS float* mod = (LAS float*)(lds + 66048);
    LAS float* lgt = (LAS float*)(lds + 74240);
    LAS unsigned* hist = (LAS unsigned*)(lds + 108032); LAS unsigned* base = hist + 128;
    const int fr = lane & 15, fq = lane >> 4;
    for (int i = tid; i < 32 * 128; i += 512) { const int n = i >> 7, c = i & 127; *(LAS u32x4*)(wl + n * WPITCH + c * 16) = *(const u32x4*)(WR + n * 1024 + c * 8); }
    for (int t0 = vcu * 256; t0 < T; t0 += G * 256) {
        const int b = t0 >> 13;
        __syncthreads();
        for (int k = tid; k < 1024; k += 512) { mod[k] = gain[k] * (1.f + sc[b * 6144 + k]); mod[1024 + k] = sh[b * 6144 + k]; }
        if (tid < 32) hist[tid] = 0u;
        __syncthreads();
#pragma unroll 1
        for (int g_ = 0; g_ < (PROBE_DUP == 6 ? 4 : 2); ++g_) { const int g = g_ & 1;
            const int lrow = wave * 32 + g * 16;
            const h16* xp = (const h16*)x1 + (size_t)(t0 + lrow + fr) * 2048 + 1024 + 16 * fq;
            unsigned xa[16][8]; float ss = 0.f, ss2 = 0.f;
#pragma unroll
            for (int kk = 0; kk < 16; ++kk) {
                const u32x4 v0 = *(const u32x4*)(xp + 64 * kk), v1 = *(const u32x4*)(xp + 64 * kk + 8);
#pragma unroll
                for (int j = 0; j < 4; ++j) { xa[kk][j] = v0[j]; xa[kk][4 + j] = v1[j]; }
#pragma unroll
                for (int j = 0; j < 4; ++j) { const unsigned w0 = xa[kk][j], w1 = xa[kk][4 + j];
                    const f16x2 p0 = __builtin_bit_cast(f16x2, w0), p1 = __builtin_bit_cast(f16x2, w1);
                    ss = __builtin_amdgcn_fdot2(p0, p0, ss, false); ss2 = __builtin_amdgcn_fdot2(p1, p1, ss2, false); }
            }
            ss += ss2;
            ss += __shfl_xor(ss, 16); ss += __shfl_xor(ss, 32);
            const float rs = rsqrtf(ss * (1.f / 1024.f) + EPS);
            f32x4 acc0 = {0.f, 0.f, 0.f, 0.f}, acc1 = {0.f, 0.f, 0.f, 0.f};
            unsigned char* hp = H8 + (size_t)(t0 + lrow + fr) * 1024 + 16 * fq;
#pragma unroll
            for (int kk = 0; kk < 16; ++kk) {
                float y[16];
#pragma unroll
                for (int j = 0; j < 4; ++j) { const f32x4 s4 = *(LAS f32x4*)(mod + 64 * kk + 16 * fq + 4 * j), h4 = *(LAS f32x4*)(mod + 1024 + 64 * kk + 16 * fq + 4 * j);
                    const f16x2 p0 = __builtin_bit_cast(f16x2, xa[kk][2 * j]), p1 = __builtin_bit_cast(f16x2, xa[kk][2 * j + 1]);
                    y[4 * j + 0] = (float)p0[0] * rs * s4[0] + h4[0]; y[4 * j + 1] = (float)p0[1] * rs * s4[1] + h4[1];
                    y[4 * j + 2] = (float)p1[0] * rs * s4[2] + h4[2]; y[4 * j + 3] = (float)p1[1] * rs * s4[3] + h4[3]; }
                u32x4 o8;
#pragma unroll
                for (int j = 0; j < 4; ++j) o8[j] = pk4f8(y[4 * j], y[4 * j + 1], y[4 * j + 2], y[4 * j + 3]);
                *(u32x4*)(hp + 64 * kk) = o8;
                u32x4 a0w, a1w;
#pragma unroll
                for (int j = 0; j < 4; ++j) { a0w[j] = pkh(y[2 * j], y[2 * j + 1]); a1w[j] = pkh(y[8 + 2 * j], y[8 + 2 * j + 1]); }
                const f16x8 a0 = __builtin_bit_cast(f16x8, a0w), a1 = __builtin_bit_cast(f16x8, a1w);
                LAS const unsigned char* wp = wl + fr * WPITCH + (64 * kk + 16 * fq) * 2;
                const f16x8 b00 = *(LAS const f16x8*)(wp), b01 = *(LAS const f16x8*)(wp + 16), b10 = *(LAS const f16x8*)(wp + 16 * WPITCH), b11 = *(LAS const f16x8*)(wp + 16 * WPITCH + 16);
                acc0 = __builtin_amdgcn_mfma_f32_16x16x32_f16(a0, b00, acc0, 0, 0, 0); acc1 = __builtin_amdgcn_mfma_f32_16x16x32_f16(a0, b10, acc1, 0, 0, 0);
                acc0 = __builtin_amdgcn_mfma_f32_16x16x32_f16(a1, b01, acc0, 0, 0, 0); acc1 = __builtin_amdgcn_mfma_f32_16x16x32_f16(a1, b11, acc1, 0, 0, 0);
            }
#pragma unroll
            for (int r = 0; r < 4; ++r) { lgt[(lrow + 4 * fq + r) * 33 + fr] = acc0[r]; lgt[(lrow + 4 * fq + r) * 33 + 16 + fr] = acc1[r]; }
        }
        __syncthreads();
        int e[4]; float gt[4]; unsigned lp[4]; const bool act = tid < 256; const int t = t0 + tid;
        if (act) {
            float lg[32];
#pragma unroll
            for (int k = 0; k < 32; ++k) lg[k] = lgt[tid * 33 + k] + b_router[k];
            float tv[4];
#pragma unroll
            for (int j = 0; j < 4; ++j) { float best = lg[0]; int bi = 0;
#pragma unroll
                for (int k = 1; k < 32; ++k) { if (lg[k] > best) { best = lg[k]; bi = k; } }
#pragma unroll
                for (int k = 0; k < 32; ++k) lg[k] = (k == bi) ? -INFINITY : lg[k];
                e[j] = bi; tv[j] = best; }
            float ps[4], sum = 0.f;
#pragma unroll
            for (int j = 0; j < 4; ++j) { ps[j] = __expf(tv[j] - tv[0]); sum += ps[j]; }
#pragma unroll
            for (int j = 0; j < 4; ++j) { gt[j] = ps[j] / sum; lp[j] = __hip_atomic_fetch_add(&hist[e[j]], 1u, __ATOMIC_RELAXED, __HIP_MEMORY_SCOPE_WORKGROUP); }
        }
        __syncthreads();
        if (tid < 32) { const unsigned c = hist[tid]; base[tid] = c ? atomicAdd(&CNT[tid], c) : 0u; }
        __syncthreads();
        if (act) {
#pragma unroll
            for (int j = 0; j < 4; ++j) { const int gg = e[j]; const unsigned pos = base[gg] + lp[j]; ROWINFO[(size_t)gg * 65536 + pos] = (u64)(unsigned)t | ((u64)__float_as_uint(gt[j]) << 32); TOKSLOT[(size_t)t * 4 + j] = ((unsigned)e[j] << 16) | pos; }
        }
    }
}
struct MoeTabs { LAS unsigned* cnt; LAS unsigned* ptile; LAS unsigned* rtg; LAS unsigned* tokt; };
__device__ __forceinline__ MoeTabs moe_tables(LAS unsigned char* aux, const unsigned* CNT, int tid, int lane, int wave, bool build = true) {
    MoeTabs m; m.cnt = (LAS unsigned*)aux; m.ptile = m.cnt + 128; m.rtg = m.cnt + 384; m.tokt = m.cnt + 2048;
    if (!build) return m;
    if (tid < 32) m.cnt[tid] = __hip_atomic_load(CNT + tid, __ATOMIC_RELAXED, __HIP_MEMORY_SCOPE_AGENT);
    __syncthreads();
    if (tid == 0) { unsigned p = 0; for (int g = 0; g < 32; ++g) { m.ptile[g] = p; p += (m.cnt[g] + 255u) >> 8; } m.ptile[32] = p; }
    __syncthreads();
    for (int g = wave; g < 32; g += 8) { const unsigned bs = m.ptile[g], n = m.ptile[g + 1] - bs; for (unsigned mt = lane; mt < n; mt += 64) m.rtg[bs + mt] = ((unsigned)g << 16) | mt; }
    __syncthreads();
    return m;
}

__device__ __forceinline__ void combine_phase(const MoeTabs& tb, const unsigned* TOKSLOT, const unsigned char* Y, const float* mod, float* out, int gw, int NGW, int lane) {
    for (int chunk = gw; chunk < T / 32; chunk += NGW) {
        f32x4 g2v[4];
#pragma unroll
        for (int k = 0; k < 4; ++k) g2v[k] = *(const f32x4*)(mod + ((chunk * 32) >> 13) * 6144 + 5120 + 16 * lane + 4 * k);
#pragma unroll 1
        for (int r = 0; r < 32; r += 4) {
            const size_t t0 = (size_t)chunk * 32 + r;
            f16x8 xh[4][2]; u32x4 yv[4][4];
#pragma unroll
            for (int i = 0; i < 4; ++i) {
                const size_t t = t0 + i;
                const u32x4 ts = *(const u32x4*)(TOKSLOT + t * 4);
                const h16* xp = (const h16*)out + t * 2048 + 1024 + 16 * lane;
                xh[i][0] = *(const f16x8*)xp; xh[i][1] = *(const f16x8*)(xp + 8);
                const unsigned v0 = ts[0], v1 = ts[1], v2 = ts[2], v3 = ts[3];
                yv[i][0] = *(const u32x4*)(Y + ((size_t)tb.ptile[v0 >> 16] * 256 + (v0 & 0xffffu)) * 1024 + 16 * lane);
                yv[i][1] = *(const u32x4*)(Y + ((size_t)tb.ptile[v1 >> 16] * 256 + (v1 & 0xffffu)) * 1024 + 16 * lane);
                yv[i][2] = *(const u32x4*)(Y + ((size_t)tb.ptile[v2 >> 16] * 256 + (v2 & 0xffffu)) * 1024 + 16 * lane);
                yv[i][3] = *(const u32x4*)(Y + ((size_t)tb.ptile[v3 >> 16] * 256 + (v3 & 0xffffu)) * 1024 + 16 * lane);
            }
            asm volatile("s_waitcnt vmcnt(0)" ::: "memory");
#pragma unroll
            for (int i = 0; i < 4; ++i) {
                unsigned yw[4][4];
#pragma unroll
                for (int j = 0; j < 4; ++j) { yw[j][0] = yv[i][j].x; yw[j][1] = yv[i][j].y; yw[j][2] = yv[i][j].z; yw[j][3] = yv[i][j].w; }
#pragma unroll
                for (int k = 0; k < 4; ++k) {
                    f32x4 s = {0.f, 0.f, 0.f, 0.f}, xv;
#pragma unroll
                    for (int q = 0; q < 4; ++q) xv[q] = (float)xh[i][k >> 1][(k & 1) * 4 + q];
#pragma unroll
                    for (int j = 0; j < 4; ++j) { const f32x2 lo = __builtin_amdgcn_cvt_pk_f32_bf8((int)yw[j][k], false), hi = __builtin_amdgcn_cvt_pk_f32_bf8((int)yw[j][k], true);
                        s[0] += lo[0]; s[1] += lo[1]; s[2] += hi[0]; s[3] += hi[1]; }
                    *(f32x4*)(out + (t0 + i) * 1024 + 16 * lane + 4 * k) = xv + g2v[k] * s; }
            }
        }
    }
}

#ifndef MK_LAUNCHES
#define MK_LAUNCHES 1
#endif
constexpr int NPH = 10;
struct Args { const float* in[26]; float* out; unsigned char* ws; int ph_lo, ph_hi, li, use_bar; };

__global__ void __launch_bounds__(512, 2) hybrid_fwd(Args a) {
    extern __shared__ __attribute__((aligned(16))) unsigned char lds_raw[];
    LAS unsigned char* lds = (LAS unsigned char*)lds_raw;
    volatile LAS unsigned* MISC = (volatile LAS unsigned*)(lds + MISC_OFF);
    const int G = gridDim.x, bx = blockIdx.x;
    const int vcu = (G % 8 == 0) ? (bx % 8) * (G / 8) + bx / 8 : bx;
    const int NGW = G * 8;
#define PHASE_IDS() int tid = threadIdx.x; asm volatile("" : "+v"(tid)); const int lane = tid & 63, wave = __builtin_amdgcn_readfirstlane(tid >> 6); const int gw = vcu * 8 + wave; (void)lane; (void)gw
    if (threadIdx.x < 64) MISC[threadIdx.x] = 0u;
    __syncthreads();
    unsigned char* ws = a.ws;
    unsigned* ctl = (unsigned*)(ws + WS_CTL);
    XcdBarrier bar; bar.bar = ctl + CW_BAR + a.li * XCD_BAR_WORDS; bar.x = 0; bar.st = nullptr;
    if (a.use_bar) bar = xcd_barrier_post(ctl + CW_BAR + a.li * XCD_BAR_WORDS, MISC + 8);
    const int lo = a.ph_lo, hi = a.ph_hi;
#ifndef ONLY_PHASE
#define ONLY_PHASE -1
#endif
#define PEN(k) (ONLY_PHASE < 0 || ONLY_PHASE == (k) || (ONLY_PHASE / 10 == (k) && ONLY_PHASE >= 30))
#define SUBEN(k) (ONLY_PHASE < 30 || ONLY_PHASE == (k))
#define IN(k) (PEN(k) && lo <= (k) && (k) < hi)
#define SEAM(k) do { if (IN(k) && IN((k) + 1)) xcd_barrier(bar); } while (0)
#define DUP(k) _Pragma("unroll 1") for (int rep_ = 0; rep_ < ((PROBE_DUP == (k)) ? 2 : 1); ++rep_)
#define DUPBAR(k) do { if (PROBE_DUP == (k) && rep_ == 0) xcd_barrier(bar); } while (0)
    float* const out = a.out;
#define INP(i) (a.in[i])
#define WSP(T_, off) ((T_*)(ws + (off)))
    unsigned* const CNT = ctl + CW_CNT;

    if (IN(0)) DUP(0) {
        PHASE_IDS();
        mod_phase(lds, INP(1), INP(2), INP(3), WSP(float, WS_MOD), tid, G);
        __syncthreads();
        P0Args pa{INP(5), INP(18), INP(16), INP(17), INP(22), INP(24), INP(20), INP(8), INP(10), WSP(h16, WS_WIN), WSP(h16, WS_WOUT), WSP(unsigned char, WS_W1), WSP(unsigned char, WS_W2), WSP(h16, WS_WROUT), WSP(h16, WS_WRG)};
        convert_phase(lds, pa, tid, lane, wave, gw, NGW);
        DUPBAR(0);
    }
    SEAM(0);
    if (IN(1)) { PHASE_IDS(); rmsnorm_rows(INP(0), WSP(h16, WS_A), nullptr, INP(4), WSP(float, WS_MOD) + 1024, WSP(float, WS_MOD), gw, NGW, lane); }
    SEAM(1);
    if (IN(2)) DUP(2) {
        pg8::StaticOrder S; S.init(T, NIN_TILES * 256, G, bx);
        pg8::EpiInProj E{WSP(u16, WS_XR), WSP(h16, WS_KI), WSP(float, WS_WI), INP(13), INP(14), INP(15)};
        pg8::gemm_phase<pg8::EpiInProj, pg8::StaticOrder, true, 0>(lds + RING_OFF, WSP(h16, WS_A), WSP(h16, WS_WIN), 1024, S, E);
        DUPBAR(2);
    }
    SEAM(2);
    if (IN(3)) {
        if (SUBEN(30)) DUP(30) { PHASE_IDS();
        rg_phase(lds, WSP(h16, WS_XR), INP(6), INP(7), WSP(h16, WS_WRG), INP(9), INP(11), INP(12), WSP(h16, WS_HL), WSP(h16, WS_AC), WSP(float, WS_SUMP), WSP(float, WS_SUMH), tid, lane, wave, G); DUPBAR(30); }
        __syncthreads();
        if (SUBEN(31)) DUP(31) { PHASE_IDS();
        idx_phase(lds, WSP(h16, WS_QI), WSP(h16, WS_KI), WSP(float, WS_WI), WSP(unsigned, WS_MASK), tid, lane, wave, G); DUPBAR(31); }
    }
    SEAM(3);
    if (IN(4)) {
        if (SUBEN(40)) DUP(40) { PHASE_IDS();
        r3_phase(lds, WSP(h16, WS_HL), WSP(h16, WS_AC), WSP(h16, WS_XG), WSP(float, WS_SUMP), WSP(float, WS_SUMH), WSP(h16, WS_A), tid, lane, wave, G); DUPBAR(40); }
        __syncthreads();
        if (SUBEN(41)) DUP(41) {
        const attn_body::AttnTensors AT{WSP(const attn_body::bf16, WS_Q), WSP(const attn_body::bf16, WS_K), WSP(const attn_body::bf16, WS_V), WSP(_Float16, WS_A), WSP(const unsigned, WS_MASK), WSP(float, WS_SSQ8)};
        const attn_body::StaticOrder S(G, bx);
        attn_body::attn_phase<attn_body::StaticOrder>((char*)lds_raw + RING_OFF, AT, S);
        DUPBAR(41); }
    }
    SEAM(4);
    if (IN(5)) DUP(5) {
        pg8::StaticOrder S; S.init(T, 1024, G, bx);
        LAS float* rl = (LAS float*)(lds + AUX_OFF);
        { PHASE_IDS(); pg8::Unit u; const float* ssq = WSP(float, WS_SSQ8);
          for (int i = 0; i < 16 && S.next(i, u); ++i) {
              if (tid < 256) { const size_t row = (size_t)u.pm * 256 + tid; const f32x4 s0 = *(const f32x4*)(ssq + row * 8), s1 = *(const f32x4*)(ssq + row * 8 + 4);
                  rl[i * 256 + tid] = rsqrtf((((s0[0] + s0[1]) + (s0[2] + s0[3])) + ((s1[0] + s1[1]) + (s1[2] + s1[3]))) * (1.f / 512.f) + EPS); } }
          __syncthreads(); }
        pg8::EpiOutProj E{INP(0), out, WSP(float, WS_MOD), rl};
        pg8::gemm_phase<pg8::EpiOutProj, pg8::StaticOrder, true, 8>(lds + RING_OFF, WSP(h16, WS_A), WSP(h16, WS_WOUT), 1024, S, E);
        DUPBAR(5);
    }
    SEAM(5);
    if (IN(6)) { PHASE_IDS();
        norm_route_phase(lds, out, WSP(unsigned char, WS_H8), INP(19), WSP(float, WS_MOD) + 4096, WSP(float, WS_MOD) + 3072, WSP(h16, WS_WROUT), INP(21), CNT, WSP(u64, WS_ROWINFO), WSP(unsigned, WS_TOKSLOT), tid, lane, wave, G, vcu);
    }
    SEAM(6);
    if (IN(7)) DUP(9) {
        PHASE_IDS();
        const MoeTabs tb = moe_tables(lds + AUX_OFF, CNT, tid, lane, wave);
        const int nrt = (int)tb.ptile[32];
        const int cpx = (G % 32 == 0) ? 32 : 8, ngrp = G / cpx;
        pg8::MoeSched<true> S{nrt, 0, 8, cpx / 8, ngrp, bx % ngrp, (bx / ngrp) % cpx, 2048, tb.rtg, (LAS const u16*)tb.tokt};
        { pg8::Unit u; LAS u16* tk = (LAS u16*)tb.tokt;
          for (int i = 0; i < 40 && S.next(i, u); ++i) {
              if (tid < 256) { const int g = (u.aux >> 16) & 127, mt = u.aux & 0xffff; const int idx = mt * 256 + tid;
                  tk[i * 256 + tid] = idx < (int)tb.cnt[g] ? (u16)(unsigned)WSP(u64, WS_ROWINFO)[(size_t)g * 65536 + idx] : (u16)0; } } }
        __syncthreads();
        pg8::EpiGemm1 E{WSP(unsigned char, WS_ACT), INP(23)};
        pg8::gemm_phase<pg8::EpiGemm1, pg8::MoeSched<true>, true, 0, true>(lds + RING_OFF, WSP(unsigned char, WS_H8), WSP(unsigned char, WS_W1), 1024, S, E);
        DUPBAR(9);
    }
    SEAM(7);
    if (IN(8)) {
        PHASE_IDS();
        const MoeTabs tb = moe_tables(lds + AUX_OFF, CNT, tid, lane, wave, !IN(7));
        const int nrt = (int)tb.ptile[32];
        const int cpx = (G % 32 == 0) ? 32 : 4, ngrp = G / cpx;
        pg8::MoeSched<false> S{nrt, 0, 4, cpx / 4, ngrp, bx % ngrp, (bx / ngrp) % cpx, 1024, tb.rtg, (LAS const u16*)tb.tokt};
        LAS unsigned* rtab = (LAS unsigned*)tb.tokt;
        { pg8::Unit u;
          for (int i = 0; i < 20 && S.next(i, u); ++i) {
              if (tid < 256) { const int g = (u.aux >> 16) & 127, mt = u.aux & 0xffff; const int idx = mt * 256 + tid; unsigned v = 0u;
                  if (idx < (int)tb.cnt[g]) { const u64 ri = WSP(u64, WS_ROWINFO)[(size_t)g * 65536 + idx]; v = ((unsigned)ri & 0xffffu) | (pkh(0.f, __uint_as_float((unsigned)(ri >> 32))) & 0xffff0000u); }
                  rtab[i * 256 + tid] = v; } } }
        __syncthreads();
        pg8::EpiGemm2 E{WSP(unsigned char, WS_Y), INP(25), rtab, tb.cnt};
        pg8::gemm_phase<pg8::EpiGemm2, pg8::MoeSched<false>, true, 0, true>(lds + RING_OFF, WSP(unsigned char, WS_ACT), WSP(unsigned char, WS_W2), 1024, S, E);
    }
    SEAM(8);
    if (IN(9)) {
        PHASE_IDS();
        const MoeTabs tb = moe_tables(lds + AUX_OFF, CNT, tid, lane, wave, !IN(7));
        combine_phase(tb, WSP(unsigned, WS_TOKSLOT), WSP(unsigned char, WS_Y), WSP(float, WS_MOD), out, gw, NGW, lane);
    }
#undef IN
#undef SEAM
}

extern "C" void kernel_launch(void* const* d_in, const int* in_sizes, int n_in, void* d_out, int out_size, void* d_ws, size_t ws_size, hipStream_t stream) {
    static int grid = 0;
    if (grid == 0) {
        if (n_in != 26 || out_size != T * D || ws_size < WS_END) { fprintf(stderr, "kernel_launch: unexpected shapes (n_in %d, out %d, ws %zu)\n", n_in, out_size, ws_size); grid = -1; return; }
        int dev = 0, cus = 0, per_cu = 0;
        if (hipGetDevice(&dev) != hipSuccess || hipDeviceGetAttribute(&cus, hipDeviceAttributeMultiprocessorCount, dev) != hipSuccess) { grid = -1; return; }
        if (hipFuncSetAttribute((const void*)hybrid_fwd, hipFuncAttributeMaxDynamicSharedMemorySize, LDS_BYTES) != hipSuccess) { fprintf(stderr, "kernel_launch: hipFuncSetAttribute failed\n"); grid = -1; return; }
        if (hipOccupancyMaxActiveBlocksPerMultiprocessor(&per_cu, (const void*)hybrid_fwd, 512, LDS_BYTES) != hipSuccess || per_cu < 1) fprintf(stderr, "kernel_launch: occupancy query says %d\n", per_cu);
        (void)hipGetLastError();
        if (cus < 64) { fprintf(stderr, "kernel_launch: %d CUs (needs >= 64)\n", cus); grid = -1; return; }
        grid = cus;
    }
    if (grid < 0) return;
    if (hipMemsetAsync((char*)d_ws + WS_CTL, 0, CTL_ZERO_BYTES, stream) != hipSuccess) return;
    Args a{};
    for (int i = 0; i < 26; ++i) a.in[i] = (const float*)d_in[i];
    a.out = (float*)d_out; a.ws = (unsigned char*)d_ws;
#if MK_LAUNCHES == 1
    a.ph_lo = 0; a.ph_hi = NPH; a.li = 0; a.use_bar = 1;
    hipLaunchKernelGGL(hybrid_fwd, dim3(grid), dim3(512), LDS_BYTES, stream, a);
#else
    for (int p = 0; p < NPH; ++p) { a.ph_lo = p; a.ph_hi = p + 1; a.li = 0; a.use_bar = 0; hipLaunchKernelGGL(hybrid_fwd, dim3(grid), dim3(512), LDS_BYTES, stream, a); }
#endif
}
```

```cpp
#include <hip/hip_runtime.h>
#include <hip/hip_bf16.h>
#include <cstdio>
#include <cstdint>

#ifndef PROBE_DUP
#define PROBE_DUP -1
#endif
#define LAS __attribute__((address_space(3)))
#define GAS __attribute__((address_space(1)))
typedef _Float16 h16;
typedef _Float16 f16x8 __attribute__((ext_vector_type(8)));
typedef _Float16 f16x4 __attribute__((ext_vector_type(4)));
typedef _Float16 f16x2 __attribute__((ext_vector_type(2)));
typedef float f32x2 __attribute__((ext_vector_type(2)));
typedef float f32x4 __attribute__((ext_vector_type(4)));
typedef float f32x16 __attribute__((ext_vector_type(16)));
typedef unsigned u32x2 __attribute__((ext_vector_type(2)));
typedef unsigned u32x4 __attribute__((ext_vector_type(4)));
typedef unsigned short u16;
typedef unsigned long long u64;
typedef __bf16 bf16x2_t __attribute__((ext_vector_type(2)));

constexpr int NB = 8, SEQ = 8192, T = NB * SEQ, D = 1024, DR = 512, DA = 512, NH = 8, HD = 64;
constexpr int NE = 32, FF = 1024, TOPK = 256;
constexpr int DIN = 3144, NIN_TILES = 13;
constexpr float EPS = 1e-6f;
constexpr float ATT_C2 = 0.125f * 1.4426950408889634f;
constexpr float IDX_WSCALE = 0.125f * 0.35355339059327373f;

constexpr size_t MiB = 1u << 20;
constexpr size_t WS_CTL = 0, CTL_ZERO_BYTES = 1 * MiB;
constexpr size_t WS_SSQ = 512 * 1024;
constexpr size_t WS_MOD = 1 * MiB;
constexpr size_t WS_SUMP = 2 * MiB, WS_SUMH = 4 * MiB;
constexpr size_t WS_WIN = 6 * MiB;
constexpr size_t WS_WOUT = 13 * MiB;
constexpr size_t WS_WRG = 15 * MiB;
constexpr size_t WS_WROUT = 15 * MiB + 256 * 1024;
constexpr size_t WS_W1 = 16 * MiB;
constexpr size_t WS_H8 = 80 * MiB;
constexpr size_t WS_W2 = 144 * MiB;
constexpr size_t WS_A = 208 * MiB;
constexpr size_t WS_XR = 336 * MiB, WS_XG = 400 * MiB, WS_Q = 464 * MiB, WS_K = 528 * MiB, WS_V = 592 * MiB, WS_QI = 656 * MiB;
constexpr size_t WS_KI = 720 * MiB, WS_WI = 728 * MiB;
constexpr size_t WS_HL = 730 * MiB, WS_AC = 794 * MiB;
constexpr size_t WS_MASK = 858 * MiB;
constexpr size_t WS_ROWINFO = 1000 * MiB;
constexpr size_t WS_LOGITS = 986 * MiB;
constexpr size_t WS_ACT = 208 * MiB;
constexpr size_t WS_Y = 472 * MiB;
constexpr size_t WS_SSQ8 = 994 * MiB;
constexpr size_t WS_TOKSLOT = 1016 * MiB;
constexpr size_t WS_END = 1017 * MiB;
constexpr int ACT_MAX_ROWS = (1024 + 32) * 256;
static_assert(WS_ACT + (size_t)ACT_MAX_ROWS * 1024 <= WS_Y && WS_Y + (size_t)ACT_MAX_ROWS * 2048 <= WS_ROWINFO, "MoE buffers");
constexpr int CW_BAR = 4096;
constexpr int CW_CNT = 32768;

constexpr int RING_OFF = 0, RING_BYTES = 131072;
constexpr int AUX_OFF = 131072;
constexpr int LDS_BYTES = 163840;
constexpr int MISC_OFF = LDS_BYTES - 256;

__device__ __forceinline__ unsigned pkh(float lo, float hi) { f32x2 v = {lo, hi}; f16x2 h = __builtin_convertvector(v, f16x2); return __builtin_bit_cast(unsigned, h); }
typedef int v8i __attribute__((ext_vector_type(8)));
constexpr float W1_F8_SCALE = 32.f, W2_F8_SCALE = 32.f, ACT_F8_SCALE = 4.f;
__device__ __forceinline__ unsigned pk4f8(float a, float b, float c, float d) { int w = 0; w = __builtin_amdgcn_cvt_pk_fp8_f32(a, b, w, false); w = __builtin_amdgcn_cvt_pk_fp8_f32(c, d, w, true); return (unsigned)w; }
__device__ __forceinline__ unsigned pk4bf8(float a, float b, float c, float d) { int w = 0; w = __builtin_amdgcn_cvt_pk_bf8_f32(a, b, w, false); w = __builtin_amdgcn_cvt_pk_bf8_f32(c, d, w, true); return (unsigned)w; }
__device__ __forceinline__ unsigned pkb(float lo, float hi) { f32x2 v = {lo, hi}; bf16x2_t h = __builtin_convertvector(v, bf16x2_t); return __builtin_bit_cast(unsigned, h); }
__device__ __forceinline__ float wave_sum(float v) {
#pragma unroll
    for (int o = 1; o < 64; o <<= 1) v += __shfl_xor(v, o);
    return v;
}
__device__ __forceinline__ float sigmoidf_(float x) { return __builtin_amdgcn_rcpf(1.f + __expf(-x)); }

#define XB_TMO      128
#define XB_XCNT(j)  (256  + 64 * (j))
#define XB_XSUB(j)  (1280 + 64 * (j))
#define XB_XGEN(j)  (2304 + 64 * (j))
#define XB_TOP      3328
#define XB_TOPGEN   3392
#define XCD_BAR_WORDS 3456
#define XB_SPIN_CAP (1u << 18)

__device__ __forceinline__ unsigned xb_ld(unsigned* p)              { return __hip_atomic_load(p, __ATOMIC_RELAXED, __HIP_MEMORY_SCOPE_AGENT); }
__device__ __forceinline__ unsigned xb_add(unsigned* p, unsigned v) { return __hip_atomic_fetch_add(p, v, __ATOMIC_RELAXED, __HIP_MEMORY_SCOPE_AGENT); }
__device__ __forceinline__ unsigned xb_xcc_id() { return (unsigned)__builtin_amdgcn_s_getreg((3 << 11) | 20) & 0xFu; }
#define XB_SPIN(cond, bar) do { unsigned _sp = 0; while (cond) { __builtin_amdgcn_s_sleep(1); \
    if ((++_sp & 255u) == 0u) { if (xb_ld(&(bar)[XB_TMO])) break; if (_sp > XB_SPIN_CAP) { atomicAdd(&(bar)[XB_TMO], 1u); break; } } } } while (0)

struct XcdBarrier { unsigned* bar; unsigned x; volatile LAS unsigned* st; };

__device__ __forceinline__ XcdBarrier xcd_barrier_post(unsigned* bar, volatile LAS unsigned* st) {
    XcdBarrier b; b.bar = bar; b.x = xb_xcc_id(); b.st = st;
    if (threadIdx.x == 0) (void)xb_add(&bar[XB_XCNT(b.x)], 1u);
    return b;
}
__device__ __forceinline__ void xcd_barrier_complete(unsigned* bar, unsigned x, unsigned& nloc, unsigned& nx) {
    const unsigned G = gridDim.x * gridDim.y * gridDim.z;
    unsigned sum, cnt, mine, sp = 0u;
    for (;;) {
        sum = 0u; cnt = 0u; mine = 0u;
#pragma unroll
        for (unsigned j = 0; j < 16; ++j) { const unsigned c = xb_ld(&bar[XB_XCNT(j)]); sum += c; cnt += (c > 0u) ? 1u : 0u; mine = (j == x) ? c : mine; }
        if (sum == G) break;
        __builtin_amdgcn_s_sleep(1);
        if ((++sp & 255u) == 0u) { if (xb_ld(&bar[XB_TMO])) break; if (sp > XB_SPIN_CAP) { atomicAdd(&bar[XB_TMO], 1u); break; } }
    }
    nloc = mine > 0u ? mine : 1u; nx = cnt > 0u ? cnt : 1u;
}
__device__ __forceinline__ void xcd_barrier(const XcdBarrier& b) {
    asm volatile("s_waitcnt vmcnt(0)" ::: "memory");
    __syncthreads();
    if (threadIdx.x == 0) {
        unsigned* bar = b.bar;
        __builtin_amdgcn_s_waitcnt(0);
        unsigned nloc = b.st[0], nx = b.st[1];
        if (nloc == 0u) { xcd_barrier_complete(bar, b.x, nloc, nx); b.st[0] = nloc; b.st[1] = nx; }
        const unsigned old = xb_add(&bar[XB_XSUB(b.x)], 1u);
        const unsigned gen = old / nloc;
        if (old + 1u == (gen + 1u) * nloc) {
            __builtin_amdgcn_fence(__ATOMIC_RELEASE, "agent");
            asm volatile("s_waitcnt vmcnt(0)" ::: "memory");
            const unsigned og = xb_add(&bar[XB_TOP], 1u);
            const unsigned tg = og / nx;
            if (og + 1u == (tg + 1u) * nx) xb_add(&bar[XB_TOPGEN], 1u);
            else XB_SPIN(xb_ld(&bar[XB_TOPGEN]) == tg, bar);
            __builtin_amdgcn_fence(__ATOMIC_ACQUIRE, "agent");
            xb_add(&bar[XB_XGEN(b.x)], 1u);
            asm volatile("s_waitcnt vmcnt(0)" ::: "memory");
        } else {
            XB_SPIN(xb_ld(&bar[XB_XGEN(b.x)]) == gen, bar);
            __builtin_amdgcn_fence(__ATOMIC_ACQUIRE, "agent");
            asm volatile("s_waitcnt vmcnt(0)" ::: "memory");
        }
    }
    __syncthreads();
}

namespace pg8 {
constexpr int BM = 256, BK = 64, HALF = 128, HTB = HALF * BK * 2, STAGE_BYTES = 8 * HTB, NXCD = 8, WGM = 8;
__host__ __device__ __forceinline__ int lds_byte(int r, int c) { const int st = (r >> 4) * 2 + (c >> 5), rr = r & 15, cc = c & 31, ob = rr * 64 + cc * 2; return st * 1024 + (ob ^ (((ob >> 9) & 1) << 5)); }
__host__ __device__ __forceinline__ void stage_rc(int b, int& R, int& C) { const int st = b / 1024, sb = b % 1024, swz = sb ^ (((sb >> 9) & 1) << 5); R = (st >> 1) * 16 + swz / 64; C = (st & 1) * 32 + (swz % 64) / 2; }
__host__ __device__ __forceinline__ int perm32(int rho) { const int n = rho >> 4, i = rho & 15; return 8 * (i >> 2) + 4 * n + (i & 3); }

struct Unit { int pm, pn, aux, ord; };

struct StaticOrder {
    int nM, nN, nwg, G, c;
    __device__ void init(int M, int N, int G_, int c_) { nM = M / BM; nN = N / BM; nwg = nM * nN; G = G_; c = c_; }
    __device__ bool next(int i, Unit& u) const {
        const long L = (long)i * G + c; if (L >= nwg) return false;
        int wgid = (int)L; { const int q = nwg / NXCD, r = nwg % NXCD, xcd = wgid % NXCD, off = wgid / NXCD; wgid = (xcd < r ? xcd * (q + 1) : r * (q + 1) + (xcd - r) * q) + off; }
        const int nig = WGM * nN, gid = wgid / nig, fm = gid * WGM, gsz = (nM - fm) < WGM ? (nM - fm) : WGM;
        u.pm = fm + ((wgid % nig) % gsz); u.pn = (wgid % nig) / gsz; u.aux = 0; u.ord = i; return true;
    }
    __device__ __forceinline__ unsigned arow(const Unit& u, int r) const { return (unsigned)(u.pm * BM + r); }
    __device__ __forceinline__ unsigned brow0(const Unit& u) const { return (unsigned)(u.pn * BM); }
};

template <bool GATHER> struct MoeSched {
    int nrt, rt_base, npn, rps, ngrp, grp, c, bstride;
    LAS const unsigned* rtg; LAS const u16* tokt;
    __device__ __forceinline__ bool next(int i, Unit& u) const { const int rr = (i * ngrp + grp) * rps + c / npn; if (rr >= nrt) return false; u.pm = rt_base + rr; u.pn = c % npn; u.aux = (int)rtg[u.pm]; u.ord = i; return true; }
    __device__ __forceinline__ unsigned arow(const Unit& u, int r) const { if constexpr (GATHER) return (unsigned)tokt[u.ord * 256 + r]; else return (unsigned)(u.pm * BM + r); }
    __device__ __forceinline__ unsigned brow0(const Unit& u) const { return (unsigned)(((u.aux >> 16) & 31) * bstride + u.pn * BM); }
};

typedef f32x4 Acc[2][2][4][2];
typedef int i32x4_ __attribute__((ext_vector_type(4)));

template <class Epi, class Sched, bool ALIGN_EPI, int MIDT, bool F8 = false>
__device__ __forceinline__ void gemm_phase(LAS unsigned char* lds, const void* A, const void* Bt, const int K, const Sched& S, const Epi& E, const unsigned apitch = 0u) {
    int tid = threadIdx.x; asm volatile("" : "+v"(tid));
    const int wid = __builtin_amdgcn_readfirstlane(tid >> 6), lane = tid & 63, wr = wid >> 2, wc = wid & 3, fr = lane & 15, fq = lane >> 4;
    constexpr int ES = F8 ? 1 : 2;
    const int nt = K * ES / (BK * 2);
    int RA[2]; unsigned CA[2], voffB[2];
#pragma unroll
    for (int i = 0; i < 2; ++i) { int R, C; stage_rc(tid * 16 + i * 8192, R, C); const int Rb = (R & ~31) + perm32(R & 31); RA[i] = R; CA[i] = (unsigned)C * 2u; voffB[i] = (unsigned)(Rb * K * ES + C * 2); }
    const size_t kstep = (size_t)(BK * 2);
    const size_t hstepB = (size_t)HALF * K * ES;
    const unsigned rowb = (unsigned)(K * ES);
    const unsigned rowa = apitch ? apitch : rowb;
    const unsigned ldsw = (unsigned)wid * 1024u;
    const int aoff = lds_byte(wr * 64 + fr, fq * 8), boff = lds_byte(wc * 32 + fr, fq * 8);
#define PG8_SA(b, h) (((b) * 2 + (h)) * HTB)
#define PG8_SB(b, h) ((4 + (b) * 2 + (h)) * HTB)
#define PG8_STAGEB(bufoff, gbase) do { _Pragma("unroll") for (int _i = 0; _i < 2; ++_i) \
        __builtin_amdgcn_global_load_lds((const unsigned*)((const char*)(gbase) + voffB[_i]), (LAS unsigned*)(lds + (bufoff) + ldsw + _i * 8192), 16, 0, 0); } while (0)
#define PG8_STAGEA(bufoff, OFFS, h, kb) do { _Pragma("unroll") for (int _i = 0; _i < 2; ++_i) \
        __builtin_amdgcn_global_load_lds((const unsigned*)((const char*)A + (size_t)(OFFS)[h][_i] + (size_t)(kb)), (LAS unsigned*)(lds + (bufoff) + ldsw + _i * 8192), 16, 0, 0); } while (0)
#define PG8_AOFFS(U, O) do { _Pragma("unroll") for (int _h = 0; _h < 2; ++_h) _Pragma("unroll") for (int _i = 0; _i < 2; ++_i) (O)[_h][_i] = S.arow(U, _h * HALF + RA[_i]) * rowa + CA[_i]; } while (0)
#define PG8_LD8(p) __builtin_shufflevector(*(const LAS i32x4_*)(p), *(const LAS i32x4_*)((p) + 1024), 0, 1, 2, 3, 4, 5, 6, 7)
#define PG8_LDA(dst, b, h) do { _Pragma("unroll") for (int m = 0; m < 4; ++m) dst[m] = PG8_LD8(lds + PG8_SA(b, h) + aoff + m * 2048); } while (0)
#define PG8_LDB(dst, b, h) do { _Pragma("unroll") for (int n = 0; n < 2; ++n) dst[n] = PG8_LD8(lds + PG8_SB(b, h) + boff + n * 2048); } while (0)
#define PG8_H0(X) __builtin_bit_cast(f16x8, __builtin_shufflevector(X, X, 0, 1, 2, 3))
#define PG8_H1(X) __builtin_bit_cast(f16x8, __builtin_shufflevector(X, X, 4, 5, 6, 7))
#define PG8_MMA(ai, bj, At, Bt_) do { __builtin_amdgcn_s_setprio(1); _Pragma("unroll") for (int m = 0; m < 4; ++m) _Pragma("unroll") for (int n = 0; n < 2; ++n) { \
        if constexpr (F8) asm volatile("v_mfma_scale_f32_16x16x128_f8f6f4 %0, %1, %2, %0, %3, %3 op_sel_hi:[0,0,0]" : "+v"(acc[ai][bj][m][n]) : "v"(Bt_[n]), "v"(At[m]), "v"(f8scale));   \
        else { acc[ai][bj][m][n] = __builtin_amdgcn_mfma_f32_16x16x32_f16(PG8_H0(Bt_[n]), PG8_H0(At[m]), acc[ai][bj][m][n], 0, 0, 0); \
               acc[ai][bj][m][n] = __builtin_amdgcn_mfma_f32_16x16x32_f16(PG8_H1(Bt_[n]), PG8_H1(At[m]), acc[ai][bj][m][n], 0, 0, 0); } } \
        __builtin_amdgcn_s_setprio(0); } while (0)
#define PG8_WAIT_V(n) asm volatile("s_waitcnt vmcnt(" #n ")" ::: "memory")
#define PG8_WAIT_L(n) asm volatile("s_waitcnt lgkmcnt(" #n ")" ::: "memory")
#define PG8_BAR __builtin_amdgcn_s_barrier()
#define PG8_SCHED __builtin_amdgcn_sched_barrier(0)
    Unit cur, nxt; int ui = 0;
    if (!S.next(0, cur)) return;
    Acc acc;
    E.acc_set(acc, E.pre(cur, wr, wc, fr, fq));
    const unsigned f8scale = 0x7f7f7f7fu;
    v8i At[4], B0[2], B1[2];
    unsigned curA[2][2], nxtA[2][2];
    PG8_AOFFS(cur, curA);
    const char* cB = (const char*)Bt + (size_t)S.brow0(cur) * rowb;
    PG8_STAGEB(PG8_SB(0, 0), cB); PG8_STAGEB(PG8_SB(0, 1), cB + hstepB); PG8_STAGEA(PG8_SA(0, 0), curA, 0, 0); PG8_STAGEA(PG8_SA(0, 1), curA, 1, 0);
    if (wr == 1) PG8_BAR;
    PG8_WAIT_V(2); PG8_BAR;
    PG8_STAGEB(PG8_SB(1, 0), cB + kstep); PG8_STAGEA(PG8_SA(1, 0), curA, 0, kstep); PG8_STAGEB(PG8_SB(1, 1), cB + hstepB + kstep);
    PG8_WAIT_V(6); PG8_BAR;
    for (;;) {
        const bool has_next = S.next(ui + 1, nxt);
        const char* nB = cB;
        if (has_next) { PG8_AOFFS(nxt, nxtA); nB = (const char*)Bt + (size_t)S.brow0(nxt) * rowb; }
        else {
#pragma unroll
            for (int h = 0; h < 2; ++h)
#pragma unroll
                for (int i = 0; i < 2; ++i) nxtA[h][i] = curA[h][i];
        }
        for (int t = 0; t < nt; t += 2) {
            const bool last = (t == nt - 2);
            const size_t kb1 = (size_t)(t + 1) * kstep;
            unsigned selA[2][2];
#pragma unroll
            for (int h = 0; h < 2; ++h)
#pragma unroll
                for (int i = 0; i < 2; ++i) selA[h][i] = last ? nxtA[h][i] : curA[h][i];
            const size_t kb2 = last ? (size_t)0 : (size_t)(t + 2) * kstep, kb3 = kb2 + kstep;
            const char* b2 = last ? nB : cB + (size_t)(t + 2) * kstep; const char* b3 = b2 + kstep;
            PG8_LDB(B0, 0, 0); PG8_LDB(B1, 0, 1); PG8_SCHED; PG8_LDA(At, 0, 0); PG8_STAGEA(PG8_SA(1, 1), curA, 1, kb1);
            PG8_WAIT_V(8); PG8_WAIT_L(0); PG8_BAR; PG8_MMA(0, 0, At, B0); PG8_MMA(0, 1, At, B1); PG8_BAR; PG8_SCHED;
            PG8_LDA(At, 0, 1); PG8_STAGEB(PG8_SB(0, 0), b2); PG8_STAGEB(PG8_SB(0, 1), b2 + hstepB); PG8_STAGEA(PG8_SA(0, 0), selA, 0, kb2);
            PG8_WAIT_V(8); PG8_WAIT_L(0); PG8_BAR; PG8_MMA(1, 0, At, B0); PG8_MMA(1, 1, At, B1); PG8_BAR; PG8_SCHED;
            PG8_LDB(B0, 1, 0); PG8_LDB(B1, 1, 1); PG8_SCHED; PG8_LDA(At, 1, 0); PG8_STAGEA(PG8_SA(0, 1), selA, 1, kb2);
            PG8_WAIT_V(8); PG8_WAIT_L(0); PG8_BAR; PG8_MMA(0, 0, At, B0); PG8_MMA(0, 1, At, B1); PG8_BAR; PG8_SCHED;
            PG8_LDA(At, 1, 1); PG8_STAGEB(PG8_SB(1, 0), b3); PG8_STAGEB(PG8_SB(1, 1), b3 + hstepB); PG8_STAGEA(PG8_SA(1, 0), selA, 0, kb3);
            PG8_WAIT_V(8); PG8_WAIT_L(0); PG8_BAR; PG8_MMA(1, 0, At, B0); PG8_MMA(1, 1, At, B1); PG8_BAR; PG8_SCHED;
            if constexpr (MIDT > 0) { if (t + 2 == MIDT) E.mid(acc, cur, wr, wc, fr, fq); }
        }
        if constexpr (ALIGN_EPI) { if (wr == 0) PG8_BAR; }
        if constexpr (F8) asm volatile("s_nop 15\n\ts_nop 15" ::: "memory");
        typename Epi::Pre pre_; if (has_next) pre_ = E.pre(nxt, wr, wc, fr, fq);
        if constexpr (PROBE_DUP == Epi::PID) E(acc, cur, wr, wc, fr, fq);
        E(acc, cur, wr, wc, fr, fq);
        if (!has_next) break;
        E.acc_set(acc, pre_);
        cur = nxt; cB = nB; ++ui;
#pragma unroll
        for (int h = 0; h < 2; ++h)
#pragma unroll
            for (int i = 0; i < 2; ++i) curA[h][i] = nxtA[h][i];
        if constexpr (ALIGN_EPI) { if (wr == 1) PG8_BAR; }
    }
    PG8_WAIT_V(0);
    if constexpr (!ALIGN_EPI) { if (wr == 0) PG8_BAR; }
    PG8_BAR;
#undef PG8_SA
#undef PG8_SB
#undef PG8_STAGEA
#undef PG8_STAGEB
#undef PG8_AOFFS
#undef PG8_LDA
#undef PG8_LDB
#undef PG8_MMA
#undef PG8_H0
#undef PG8_H1
#undef PG8_LD8
#undef PG8_WAIT_V
#undef PG8_WAIT_L
#undef PG8_BAR
#undef PG8_SCHED
}

__device__ __forceinline__ u32x4 pack8h(const f32x4 a, const f32x4 b) { u32x4 w; w.x = pkh(a[0], a[1]); w.y = pkh(a[2], a[3]); w.z = pkh(b[0], b[1]); w.w = pkh(b[2], b[3]); return w; }
__device__ __forceinline__ u32x4 pack8b(const f32x4 a, const f32x4 b) { u32x4 w; w.x = pkb(a[0], a[1]); w.y = pkb(a[2], a[3]); w.z = pkb(b[0], b[1]); w.w = pkb(b[2], b[3]); return w; }

struct NoPre {};
__device__ __forceinline__ void acc_zero(Acc& acc) {
#pragma unroll
    for (int a = 0; a < 2; ++a)
#pragma unroll
        for (int b = 0; b < 2; ++b)
#pragma unroll
            for (int m = 0; m < 4; ++m)
#pragma unroll
                for (int n = 0; n < 2; ++n) acc[a][b][m][n] = (f32x4){0.f, 0.f, 0.f, 0.f};
}
struct EpiInProj { static constexpr int PID = 21;
    typedef NoPre Pre;
    __device__ __forceinline__ Pre pre(const Unit&, int, int, int, int) const { return Pre{}; }
    __device__ __forceinline__ void acc_set(Acc& acc, const Pre&) const { acc_zero(acc); }
    u16* base; h16* KI; float* WI; const float *qg, *kg, *kig;
    __device__ __forceinline__ void mid(Acc&, const Unit&, int, int, int, int) const {}
    __device__ __forceinline__ void headnorm(const Acc& acc, const size_t row0, int fq, const float* g, float sc, u16* dst, int pitch, int coloff, bool bf) const {
        f32x4 gv[2][2];
#pragma unroll
        for (int bj = 0; bj < 2; ++bj)
#pragma unroll
            for (int n = 0; n < 2; ++n) gv[bj][n] = *(const f32x4*)(g + 32 * bj + 8 * fq + 4 * n);
#pragma unroll
        for (int ai = 0; ai < 2; ++ai)
#pragma unroll
            for (int m = 0; m < 4; ++m) {
                float ss = 0.f;
#pragma unroll
                for (int bj = 0; bj < 2; ++bj)
#pragma unroll
                    for (int n = 0; n < 2; ++n) { const f32x4 v = acc[ai][bj][m][n]; ss += (v[0] * v[0] + v[1] * v[1]) + (v[2] * v[2] + v[3] * v[3]); }
                ss += __shfl_xor(ss, 16); ss += __shfl_xor(ss, 32);
                const float rs = rsqrtf(ss * (1.f / 64.f) + EPS) * sc;
                u16* rowp = dst + (row0 + ai * 128 + m * 16) * (size_t)pitch + coloff + 8 * fq;
#pragma unroll
                for (int bj = 0; bj < 2; ++bj) {
                    const f32x4 v0 = acc[ai][bj][m][0] * rs * gv[bj][0], v1 = acc[ai][bj][m][1] * rs * gv[bj][1];
                    *(u32x4*)(rowp + 32 * bj) = bf ? pack8b(v0, v1) : pack8h(v0, v1);
                }
            }
    }
    __device__ __forceinline__ void operator()(const Acc& acc, const Unit& u, int wr, int wc, int fr, int fq) const {
        const int pn = u.pn; const size_t row0 = (size_t)u.pm * 256 + wr * 64 + fr;
        u16* dst = base + (size_t)(pn >> 1) * (size_t)(32u << 20);
        if (pn < 4 || (pn >= 8 && pn < 12)) {
            const bool isbf = (pn == 8 || pn == 9);
            const int col0 = (pn & 1) * 256 + wc * 32 + 8 * fq;
#pragma unroll
            for (int ai = 0; ai < 2; ++ai)
#pragma unroll
                for (int m = 0; m < 4; ++m) {
                    u16* rowp = dst + (row0 + ai * 128 + m * 16) * 512 + col0;
#pragma unroll
                    for (int bj = 0; bj < 2; ++bj) *(u32x4*)(rowp + bj * 128) = isbf ? pack8b(acc[ai][bj][m][0], acc[ai][bj][m][1]) : pack8h(acc[ai][bj][m][0], acc[ai][bj][m][1]);
                }
        } else if (pn < 8) {
            const bool isq = pn < 6;
            headnorm(acc, row0, fq, isq ? qg : kg, isq ? ATT_C2 : 1.f, dst, 512, ((pn & 1) * 4 + wc) * 64, true);
        } else {
            if (wc == 0) headnorm(acc, row0, fq, kig, 1.f, (u16*)KI, 64, 0, false);
            else if (wc == 1 && fq == 0) {
#pragma unroll
                for (int ai = 0; ai < 2; ++ai)
#pragma unroll
                    for (int m = 0; m < 4; ++m) { float* p = WI + (row0 + ai * 128 + m * 16) * 8; *(f32x4*)p = acc[ai][0][m][0]; *(f32x4*)(p + 4) = acc[ai][0][m][1]; }
            }
        }
    }
};

struct EpiOutProj { static constexpr int PID = 51;
    typedef NoPre Pre;
    __device__ __forceinline__ Pre pre(const Unit&, int, int, int, int) const { return Pre{}; }
    __device__ __forceinline__ void acc_set(Acc& acc, const Pre&) const { acc_zero(acc); }
    const float* x; float* out; const float* mod; LAS const float* rstd;
    __device__ __forceinline__ void mid(Acc& acc, const Unit& u, int wr, int wc, int fr, int fq) const {
#pragma unroll
        for (int ai = 0; ai < 2; ++ai)
#pragma unroll
            for (int m = 0; m < 4; ++m) {
                const float s = rstd[u.ord * 256 + ai * 128 + wr * 64 + m * 16 + fr];
#pragma unroll
                for (int bj = 0; bj < 2; ++bj)
#pragma unroll
                    for (int n = 0; n < 2; ++n) acc[ai][bj][m][n] = acc[ai][bj][m][n] * s;
            }
    }
    __device__ __forceinline__ void operator()(const Acc& acc, const Unit& u, int wr, int wc, int fr, int fq) const {
        const int b = u.pm >> 5; const int col0 = u.pn * 256 + wc * 32 + 8 * fq;
        const float* g1 = mod + b * 6144 + 2048 + col0;
        f32x4 gv[2][2];
#pragma unroll
        for (int bj = 0; bj < 2; ++bj)
#pragma unroll
            for (int n = 0; n < 2; ++n) gv[bj][n] = *(const f32x4*)(g1 + bj * 128 + 4 * n);
#pragma unroll
        for (int ai = 0; ai < 2; ++ai)
#pragma unroll
            for (int mh = 0; mh < 2; ++mh) {
                f32x4 xv[2][2][2]; size_t off[2];
#pragma unroll
                for (int q = 0; q < 2; ++q) { off[q] = ((size_t)u.pm * 256 + ai * 128 + wr * 64 + (2 * mh + q) * 16 + fr) * 1024 + col0;
#pragma unroll
                    for (int bj = 0; bj < 2; ++bj)
#pragma unroll
                        for (int n = 0; n < 2; ++n) xv[q][bj][n] = *(const f32x4*)(x + off[q] + bj * 128 + 4 * n); }
#pragma unroll
                for (int q = 0; q < 2; ++q)
#pragma unroll
                    for (int bj = 0; bj < 2; ++bj)
                        *(u32x4*)((h16*)out + 2 * off[q] - col0 + 1024 + bj * 128) = pack8h(xv[q][bj][0] + gv[bj][0] * acc[ai][bj][2 * mh + q][0], xv[q][bj][1] + gv[bj][1] * acc[ai][bj][2 * mh + q][1]);
            }
    }
};


struct EpiGemm1 { static constexpr int PID = 91;
    struct Pre { f32x4 v[4]; };
    __device__ __forceinline__ Pre pre(const Unit& u, int wr, int wc, int fr, int fq) const {
        const int e = (u.aux >> 16) & 31; const int f0 = u.pn * 128 + wc * 32 + 8 * fq; const float* bb = b1 + (size_t)e * 2048 + 2 * f0;
        Pre p;
#pragma unroll
        for (int q = 0; q < 4; ++q) p.v[q] = *(const f32x4*)(bb + 4 * q);
        return p; }
    __device__ __forceinline__ void acc_set(Acc& acc, const Pre& p) const {
#pragma unroll
        for (int q = 0; q < 4; ++q) {
            const float g0 = p.v[q][0] * W1_F8_SCALE, l0 = p.v[q][1] * W1_F8_SCALE, g1 = p.v[q][2] * W1_F8_SCALE, l1 = p.v[q][3] * W1_F8_SCALE;
#pragma unroll
            for (int ai = 0; ai < 2; ++ai)
#pragma unroll
                for (int m = 0; m < 4; ++m) { acc[ai][0][m][q >> 1][(2 * q) & 3] = g0; acc[ai][0][m][q >> 1][((2 * q) & 3) + 1] = g1; acc[ai][1][m][q >> 1][(2 * q) & 3] = l0; acc[ai][1][m][q >> 1][((2 * q) & 3) + 1] = l1; }
        } }
    unsigned char* act; const float* b1;
    __device__ __forceinline__ void mid(Acc&, const Unit&, int, int, int, int) const {}
    __device__ __forceinline__ void operator()(const Acc& acc, const Unit& u, int wr, int wc, int fr, int fq) const {
        const int e = (u.aux >> 16) & 31; const int f0 = u.pn * 128 + wc * 32 + 8 * fq;
#pragma unroll
        for (int ai = 0; ai < 2; ++ai)
#pragma unroll
            for (int m = 0; m < 4; ++m) {
                float o[8];
#pragma unroll
                for (int j = 0; j < 8; ++j) {
                    const float ug = acc[ai][0][m][j >> 2][j & 3] * (1.f / W1_F8_SCALE), ul = acc[ai][1][m][j >> 2][j & 3] * (1.f / W1_F8_SCALE);
                    const float glu = fminf(ug, 7.f), lin = fminf(fmaxf(ul, -7.f), 7.f);
                    o[j] = (glu * __builtin_amdgcn_rcpf(1.f + __builtin_amdgcn_exp2f(glu * (-1.702f * 1.4426950408889634f)))) * __builtin_fmaf(lin, ACT_F8_SCALE, ACT_F8_SCALE);
                }
                u32x2 w; w.x = pk4f8(o[0], o[1], o[2], o[3]); w.y = pk4f8(o[4], o[5], o[6], o[7]);
                *(u32x2*)(act + ((size_t)u.pm * 256 + ai * 128 + wr * 64 + m * 16 + fr) * 1024 + f0) = w;
            }
    }
};

struct EpiGemm2 { static constexpr int PID = 101;
    struct Pre { f32x4 v[2][2]; };
    __device__ __forceinline__ Pre pre(const Unit& u, int wr, int wc, int fr, int fq) const {
        const int e = (u.aux >> 16) & 31; const int col0 = u.pn * 256 + wc * 32 + 8 * fq;
        Pre p;
#pragma unroll
        for (int bj = 0; bj < 2; ++bj)
#pragma unroll
            for (int k = 0; k < 2; ++k) p.v[bj][k] = *(const f32x4*)(b2 + (size_t)e * 1024 + col0 + bj * 128 + 4 * k);
        return p; }
    __device__ __forceinline__ void acc_set(Acc& acc, const Pre& p) const {
#pragma unroll
        for (int ai = 0; ai < 2; ++ai)
#pragma unroll
            for (int bj = 0; bj < 2; ++bj)
#pragma unroll
                for (int m = 0; m < 4; ++m)
#pragma unroll
                    for (int k = 0; k < 2; ++k) acc[ai][bj][m][k] = p.v[bj][k] * (W2_F8_SCALE * ACT_F8_SCALE);
    }
    unsigned char* y; const float* b2; LAS const unsigned* rtab; LAS const unsigned* cnt;
    __device__ __forceinline__ void mid(Acc&, const Unit&, int, int, int, int) const {}
    __device__ __forceinline__ void operator()(const Acc& acc, const Unit& u, int wr, int wc, int fr, int fq) const {
        const int g = (u.aux >> 16) & 127, mt = u.aux & 0xffff, e = g & 31; const int n = (int)cnt[g];
        const int col0 = u.pn * 256 + wc * 32 + 8 * fq;
        LAS const unsigned* rt = rtab + u.ord * 256 + wr * 64 + fr;
#pragma unroll
        for (int ai = 0; ai < 2; ++ai)
#pragma unroll
            for (int m = 0; m < 4; ++m) {
                const int r = ai * 128 + m * 16;
                if (mt * 256 + r + wr * 64 + fr < n) {
                    const unsigned ri = rt[r];
                    f16x2 gh = __builtin_bit_cast(f16x2, ri); const float gate = (float)gh[1];
                    const float gc = gate * (1.f / (W2_F8_SCALE * ACT_F8_SCALE));
                    unsigned char* p = y + ((size_t)u.pm * 256 + r + wr * 64 + fr) * 1024 + col0;
#pragma unroll
                    for (int bj = 0; bj < 2; ++bj) {
                        const f32x4 y0 = acc[ai][bj][m][0] * gc, y1 = acc[ai][bj][m][1] * gc;
                        u32x2 w; w.x = pk4bf8(y0[0], y0[1], y0[2], y0[3]); w.y = pk4bf8(y1[0], y1[1], y1[2], y1[3]);
                        *(u32x2*)(p + bj * 128) = w;
                    }
                }
            }
    }
};
}

namespace attn_body {
using bf16=__hip_bfloat16;
using bf16x8=__attribute__((ext_vector_type(8)))short;
using s16x4=__attribute__((ext_vector_type(4)))short;
using f32x16=__attribute__((ext_vector_type(16)))float;
using u32x4=__attribute__((ext_vector_type(4)))unsigned;
constexpr int BATCH=8,NHEAD=8,SEQ=8192,D=64,DM=NHEAD*D,OPITCH=1024;
constexpr int NW=8,QBLK=32,QB=QBLK*NW,KVBLK=64,NQB=SEQ/QB;
constexpr int ATTN_PITCH=DM, ATTN_UNIT_ROWS=QB;
__device__ __forceinline__ int crow(int r,int hi){return (r&3)+8*(r>>2)+4*hi;}
#define SBAR() __builtin_amdgcn_sched_barrier(0)
__device__ __forceinline__ void cmask(f32x16&p0,f32x16&p1,int jb,int qrel,int hi){
  const float NEG=-INFINITY; int kb=64*jb+4*hi;
  #pragma unroll
  for(int r=0;r<16;++r){int kv=kb+(r&3)+8*(r>>2); if(kv>qrel)p0[r]=NEG; if(kv+32>qrel)p1[r]=NEG;}
}

constexpr int NSLOT=3, SLOTB=8192;
constexpr int LDS_K=0, LDS_V=NSLOT*SLOTB, LDS_WS=2*NSLOT*SLOTB, LDS_OST=LDS_WS+NW*64*4, LDS_BYTES=LDS_OST+NW*4096;
constexpr float C2=0.125f*1.4426950408889634f;
__device__ __forceinline__ void glds16(const void*gsrc,unsigned lds_dst){unsigned keep;
  asm volatile("s_mov_b32 %0, m0\n\ts_mov_b32 m0, %2\n\ts_nop 0\n\tglobal_load_lds_dwordx4 %1, off\n\ts_mov_b32 m0, %0":"=&s"(keep):"v"(gsrc),"s"(lds_dst):"memory");}
template<int C> __device__ __forceinline__ unsigned mbfe(unsigned w){unsigned m;asm("v_bfe_i32 %0, %1, %2, 1":"=v"(m):"v"(w),"n"(C));return m;}
__device__ __forceinline__ void glds4(const void*gsrc,unsigned lds_dst){unsigned keep;
  asm volatile("s_mov_b32 %0, m0\n\ts_mov_b32 m0, %2\n\ts_nop 0\n\tglobal_load_lds_dword %1, off\n\ts_mov_b32 m0, %0":"=&s"(keep):"v"(gsrc),"s"(lds_dst):"memory");}
__device__ __forceinline__ float max3f(float a,float b,float c){float r;asm("v_max3_f32 %0, %1, %2, %3":"=v"(r):"v"(a),"v"(b),"v"(c));return r;}
__device__ __forceinline__ float max2f(float a,float b){float r;asm("v_max_f32_e32 %0, %1, %2":"=v"(r):"v"(a),"v"(b));return r;}
__device__ __forceinline__ float fadd_s(float a,float b){float r;asm("v_add_f32_e32 %0, %1, %2":"=v"(r):"v"(a),"v"(b));return r;}
__device__ __forceinline__ float fsub_s(float a,float b){float r;asm("v_sub_f32_e32 %0, %1, %2":"=v"(r):"v"(a),"v"(b));return r;}
typedef float f32x2_t __attribute__((ext_vector_type(2))); typedef __bf16 bf16x2_t __attribute__((ext_vector_type(2)));
__device__ __forceinline__ unsigned cvtpk_s(float lo,float hi){f32x2_t v={lo,hi};bf16x2_t b=__builtin_convertvector(v,bf16x2_t);return __builtin_bit_cast(unsigned,b);}
#define WAIT_BAR(N) asm volatile("s_waitcnt vmcnt(" #N ") lgkmcnt(0)\n\ts_barrier":::"memory")

__device__ __forceinline__ void qkt(f32x16&p0,f32x16&p1,const char*Kslot,const bf16x8*qr,const f32x16&negm,int r32,int hi){
  const char*kb=Kslot+hi*1024+r32*16;
  #pragma unroll
  for(int d0=0;d0<4;++d0){
    const bf16x8 b0=*reinterpret_cast<const bf16x8*>(kb+d0*2048);
    const bf16x8 b1=*reinterpret_cast<const bf16x8*>(kb+d0*2048+512);
    if(d0==0){p0=__builtin_amdgcn_mfma_f32_32x32x16_bf16(b0,qr[0],negm,0,0,0);p1=__builtin_amdgcn_mfma_f32_32x32x16_bf16(b1,qr[0],negm,0,0,0);}
    else{p0=__builtin_amdgcn_mfma_f32_32x32x16_bf16(b0,qr[d0],p0,0,0,0);p1=__builtin_amdgcn_mfma_f32_32x32x16_bf16(b1,qr[d0],p1,0,0,0);}}
}
typedef __attribute__((address_space(3))) const char* lds_cptr;
typedef short v4i16_t __attribute__((ext_vector_type(4)));
__device__ __forceinline__ void kload8(bf16x8*kf,lds_cptr kp){
  kf[0]=*(const __attribute__((address_space(3))) bf16x8*)(kp);      kf[1]=*(const __attribute__((address_space(3))) bf16x8*)(kp+512);
  kf[2]=*(const __attribute__((address_space(3))) bf16x8*)(kp+2048); kf[3]=*(const __attribute__((address_space(3))) bf16x8*)(kp+2560);
  kf[4]=*(const __attribute__((address_space(3))) bf16x8*)(kp+4096); kf[5]=*(const __attribute__((address_space(3))) bf16x8*)(kp+4608);
  kf[6]=*(const __attribute__((address_space(3))) bf16x8*)(kp+6144); kf[7]=*(const __attribute__((address_space(3))) bf16x8*)(kp+6656);
}
__device__ __forceinline__ void kload2(bf16x8*kf,lds_cptr kp,int j){ kf[2*j]=*(const __attribute__((address_space(3))) bf16x8*)(kp+j*2048); kf[2*j+1]=*(const __attribute__((address_space(3))) bf16x8*)(kp+j*2048+512); }
__device__ __forceinline__ s16x4 vtr(lds_cptr p){ return __builtin_bit_cast(s16x4,__builtin_amdgcn_ds_read_tr16_b64_v4i16((__attribute__((address_space(3))) v4i16_t*)p)); }
__device__ __forceinline__ float rowmax(const f32x16&p0,const f32x16&p1){
  float a=max3f(p0[0],p0[1],p1[0]),b=max3f(p0[2],p0[3],p1[1]);a=max3f(a,p1[2],p1[3]);
  #pragma unroll
  for(int r=4;r<16;r+=4){a=max3f(a,p0[r],p0[r+1]);b=max3f(b,p0[r+2],p0[r+3]);a=max3f(a,p1[r],p1[r+1]);b=max3f(b,p1[r+2],p1[r+3]);}
  const float m=max2f(a,b);
  auto rr=__builtin_amdgcn_permlane32_swap(__float_as_uint(m),__float_as_uint(m),false,false);
  return max2f(__uint_as_float(rr[0]),__uint_as_float(rr[1]));
}
__device__ __forceinline__ void pv(f32x16*o,int vb,bf16x8 pa0,bf16x8 pa1,bf16x8 pa2,bf16x8 pa3){
  #pragma unroll
  for(int d0=0;d0<2;++d0){s16x4 lo[4],hi[4];
    #pragma unroll
    for(int ks=0;ks<4;++ks){
      asm volatile("ds_read_b64_tr_b16 %0,%1 offset:%c2":"=&v"(lo[ks]):"v"(vb),"i"(d0*4096+ks*1024):"memory");
      asm volatile("ds_read_b64_tr_b16 %0,%1 offset:%c2":"=&v"(hi[ks]):"v"(vb),"i"(d0*4096+ks*1024+512):"memory");}
    asm volatile("s_waitcnt lgkmcnt(0)":::"memory");SBAR();
    #define PK(k) (bf16x8){lo[k][0],lo[k][1],lo[k][2],lo[k][3],hi[k][0],hi[k][1],hi[k][2],hi[k][3]}
    o[d0]=__builtin_amdgcn_mfma_f32_32x32x16_bf16(pa0,PK(0),o[d0],0,0,0);
    o[d0]=__builtin_amdgcn_mfma_f32_32x32x16_bf16(pa1,PK(1),o[d0],0,0,0);
    o[d0]=__builtin_amdgcn_mfma_f32_32x32x16_bf16(pa2,PK(2),o[d0],0,0,0);
    o[d0]=__builtin_amdgcn_mfma_f32_32x32x16_bf16(pa3,PK(3),o[d0],0,0,0);
    #undef PK
  }
}

#ifndef ATTN_STORE16
#define ATTN_STORE16(p,v) (*(u32x4*)(p)=(v))
#endif
template<int THRL> __device__ __forceinline__ void attn_unit(int b,int h,int qb,const bf16*Q,const bf16*__restrict__ K,const bf16*__restrict__ V,_Float16*O,const unsigned*MASKP,float*SSQ,char*shm){
  int tid=threadIdx.x; asm volatile("":"+v"(tid)); const int lane=tid&63,r32=lane&31,hi=lane>>5; const int wid=__builtin_amdgcn_readfirstlane(tid>>6);
  const long rowbase=(long)b*SEQ; const int q0=qb*QB;
  const bf16*Qw=Q+(rowbase+q0+wid*QBLK)*DM+h*D;
  const bf16*Kh=K+rowbase*DM+h*D,*Vh=V+rowbase*DM+h*D;
  const unsigned lds0=(unsigned)(uintptr_t)shm;
  float*wsf=(float*)(shm+LDS_WS)+wid*64;
  const bf16*ksrc=Kh+(long)lane*DM+wid*8;
  const bf16*vsrc=Vh+(long)(16*(wid&3)+(lane>>2))*DM+(wid>>2)*32+(lane&3)*8;
  const unsigned kdst=lds0+LDS_K+wid*1024, vdst=lds0+LDS_V+wid*1024;
  #define DMA_K(t,slot) glds16(ksrc+(long)(t)*KVBLK*DM,(unsigned)__builtin_amdgcn_readfirstlane(kdst+(slot)))
  #define DMA_V(t,slot) glds16(vsrc+(long)(t)*KVBLK*DM,(unsigned)__builtin_amdgcn_readfirstlane(vdst+(slot)))
  const int vb0=(int)(lds0+LDS_V)+((lane>>4)&1)*32+(lane&3)*8+(4*hi+((lane&15)>>2))*64;
  const char*Kbase=shm+LDS_K; bf16x8 kf[8];
  const lds_cptr shm3=(lds_cptr)shm; const lds_cptr kp0=shm3+LDS_K+hi*1024+r32*16; const lds_cptr vp0=shm3+LDS_V+((lane>>4)&1)*32+(lane&3)*8+(4*hi+((lane&15)>>2))*64;
  const int NT=(q0+QB)/KVBLK;
  const unsigned*mrow=MASKP+(size_t)(rowbase+q0+wid*QBLK+(lane>>1))*256+(lane&1);
  const unsigned mdst=lds0+LDS_BYTES+wid*512;
  const lds_cptr mrd=(lds_cptr)shm+LDS_BYTES+wid*512+r32*8;
  #define MLOAD(t) glds4(mrow+2*(t),(unsigned)__builtin_amdgcn_readfirstlane(mdst+((t)&1)*256))
  #define MWORDS(t) (*(const __attribute__((address_space(3))) unsigned long long*)(mrd+((t)&1)*256))
  #define MBIT(r) (((r)&3)+8*((r)>>2))
  #define MAND(v,w,c) __uint_as_float(__float_as_uint(v)&mbfe<(c)>(w))
  #define MAND0(v,w,c) __uint_as_float(__float_as_uint(v)&(unsigned)(((int)((w)<<(31-(c))))>>31))
  MLOAD(0);MLOAD(1);
  DMA_K(0,0);DMA_V(0,0);DMA_K(1,SLOTB);
  bf16x8 qr[4];
  #pragma unroll
  for(int d0=0;d0<4;++d0)qr[d0]=*reinterpret_cast<const bf16x8*>(&Qw[(long)r32*DM+d0*16+hi*8]);
  float mhat=0.f,l_reg=0.f;f32x16 o[2];o[0]=f32x16{};o[1]=f32x16{};const f32x16 negm=f32x16{};
  const int qrel=wid*QBLK+r32;
  #define CMASK(P0,P1,t) do{int jb_=(t)-(NT-4); if(jb_>(wid>>1)){_Pragma("unroll") for(int r_=0;r_<16;++r_){P0[r_]=-INFINITY;P1[r_]=-INFINITY;}}}while(0)
  bool resc=false;
  #define START(P0,P1) do{ _Pragma("unroll") for(int r=0;r<16;++r)P0[r]=__builtin_amdgcn_exp2f(P0[r]); }while(0)
  #define RESC() do{ if(resc){ asm volatile("s_waitcnt lgkmcnt(0)":::"memory"); \
      _Pragma("unroll") for(int d_=0;d_<2;++d_) _Pragma("unroll") for(int r=0;r<16;++r)o[d_][r]*=wsf[crow(r,hi)]; } }while(0)
  f32x16 pA0,pA1,pB0,pB1;
  int sl_prev=0,sl_cur=0,sl_next=SLOTB;
  #define ROT() do{sl_prev=sl_cur;sl_cur=sl_next;sl_next=(sl_next==(NSLOT-1)*SLOTB)?0:sl_next+SLOTB;}while(0)
  DMA_K(2,2*SLOTB);
  WAIT_BAR(3);
  qkt(pA0,pA1,Kbase,qr,negm,r32,hi);asm volatile("s_nop 15\n\ts_nop 7":"+v"(pA0),"+v"(pA1));CMASK(pA0,pA1,0);
  START(pA0,pA1);
  _Pragma("unroll") for(int r=0;r<16;++r)pA1[r]=__builtin_amdgcn_exp2f(pA1[r]);
  { const unsigned long long mw_=MWORDS(0); const unsigned w0_=(unsigned)mw_>>(4*hi), w1_=(unsigned)(mw_>>32)>>(4*hi);
    _Pragma("unroll") for(int r=0;r<16;++r){pA0[r]=MAND0(pA0[r],w0_,MBIT(r));pA1[r]=MAND0(pA1[r],w1_,MBIT(r));} }
  WAIT_BAR(0);
  DMA_K(3,0);DMA_V(1,SLOTB);
  ROT();
  kload8(kf,kp0+sl_cur);
  WAIT_BAR(2);
  s16x4 vlo[8],vhi[8]; u32x4 pw0,pw1,pw2,pw3;
  #define PKW(P,B) cvtpk_s(P[B],P[B+1])
  #define PAF(k) __builtin_bit_cast(bf16x8,pw##k)
  #define VFR(i) (bf16x8){vlo[i][0],vlo[i][1],vlo[i][2],vlo[i][3],vhi[i][0],vhi[i][1],vhi[i][2],vhi[i][3]}
  #define PIN(x) asm volatile("":"+v"(x))
  #define MX3(a,b,c) __builtin_fmaxf(__builtin_fmaxf((a),(b)),(c))
  #define GAPA(MF,A0,A1,A2,A3,W0,W1,PW) do{ MF; sacc+=A0; sacc+=A1; sacc+=A2; sacc+=A3; PIN(sacc); W0; W1; PIN(PW); SBAR(); }while(0)
  #define EX(v) __builtin_amdgcn_exp2f(v)
  #define GAPB(MF,X,B,W) do{ MF; X[B]=MAND(EX(X[B]),W,MBIT(B)); X[B+1]=MAND(EX(X[B+1]),W,MBIT(B+1)); X[B+2]=MAND(EX(X[B+2]),W,MBIT(B+2)); X[B+3]=MAND(EX(X[B+3]),W,MBIT(B+3)); PIN(X); SBAR(); }while(0)
  #define VRD(i) do{ vlo[i]=vtr(vp_+(((i)>>2)*4096+((i)&3)*1024)); vhi[i]=vtr(vp_+(((i)>>2)*4096+((i)&3)*1024+512)); }while(0)
  #define KRD(G,j) do{ if(G){ kload2(kf,kp0+sl_next,j); SBAR(); } }while(0)
  #define STEP(C0,C1,P0,P1,t,GK,GV,GL,GM) do{ if(GM){MLOAD((t)+1);} SBAR(); \
    const lds_cptr vp_=vp0+sl_prev; \
    VRD(0); SBAR(); float sacc=(P0[0]+P0[1]); \
    GAPA(C0=__builtin_amdgcn_mfma_f32_32x32x16_bf16(kf[0],qr[0],negm,0,0,0), P0[2],P0[3],P0[4],P0[5],     pw0[0]=PKW(P0,0), pw0[1]=PKW(P0,2), pw0); \
    VRD(4); SBAR(); GAPA(C1=__builtin_amdgcn_mfma_f32_32x32x16_bf16(kf[1],qr[0],negm,0,0,0), P0[6],P0[7],P0[8],P0[9],     pw0[2]=PKW(P0,4), pw0[3]=PKW(P0,6), pw0); \
    VRD(1); SBAR(); GAPA(C0=__builtin_amdgcn_mfma_f32_32x32x16_bf16(kf[2],qr[1],C0,0,0,0),   P0[10],P0[11],P0[12],P0[13], pw1[0]=PKW(P0,8), pw1[1]=PKW(P0,10), pw1); \
    VRD(5); SBAR(); GAPA(C1=__builtin_amdgcn_mfma_f32_32x32x16_bf16(kf[3],qr[1],C1,0,0,0),   P0[14],P0[15],P1[0],P1[1],   pw1[2]=PKW(P0,12),pw1[3]=PKW(P0,14), pw1); \
    VRD(2); SBAR(); GAPA(C0=__builtin_amdgcn_mfma_f32_32x32x16_bf16(kf[4],qr[2],C0,0,0,0),   P1[2],P1[3],P1[4],P1[5],     pw2[0]=PKW(P1,0), pw2[1]=PKW(P1,2), pw2); \
    VRD(6); SBAR(); GAPA(C1=__builtin_amdgcn_mfma_f32_32x32x16_bf16(kf[5],qr[2],C1,0,0,0),   P1[6],P1[7],P1[8],P1[9],     pw2[2]=PKW(P1,4), pw2[3]=PKW(P1,6), pw2); \
    VRD(3); SBAR(); GAPA(C0=__builtin_amdgcn_mfma_f32_32x32x16_bf16(kf[6],qr[3],C0,0,0,0),   P1[10],P1[11],P1[12],P1[13], pw3[0]=PKW(P1,8), pw3[1]=PKW(P1,10), pw3); \
    VRD(7); SBAR(); GAPA(C1=__builtin_amdgcn_mfma_f32_32x32x16_bf16(kf[7],qr[3],C1,0,0,0),   P1[14],P1[15],0.f,0.f,       pw3[2]=PKW(P1,12),pw3[3]=PKW(P1,14), pw3); \
    l_reg+=sacc; \
    if(GK){DMA_K((t)+3,sl_cur);} if(GV){DMA_V((t)+1,sl_next);} \
    CMASK(C0,C1,t); \
    const unsigned long long mw_=MWORDS(t); const unsigned w0_=(unsigned)mw_>>(4*hi), w1_=(unsigned)(mw_>>32)>>(4*hi); \
    SBAR(); \
    GAPB(o[0]=__builtin_amdgcn_mfma_f32_32x32x16_bf16(PAF(0),VFR(0),o[0],0,0,0), C0,0,w0_); \
    GAPB(o[1]=__builtin_amdgcn_mfma_f32_32x32x16_bf16(PAF(0),VFR(4),o[1],0,0,0), C0,4,w0_); \
    KRD(GL,0); GAPB(o[0]=__builtin_amdgcn_mfma_f32_32x32x16_bf16(PAF(1),VFR(1),o[0],0,0,0), C0,8,w0_); \
    KRD(GL,1); GAPB(o[1]=__builtin_amdgcn_mfma_f32_32x32x16_bf16(PAF(1),VFR(5),o[1],0,0,0), C0,12,w0_); \
    KRD(GL,2); GAPB(o[0]=__builtin_amdgcn_mfma_f32_32x32x16_bf16(PAF(2),VFR(2),o[0],0,0,0), C1,0,w1_); \
    KRD(GL,3); GAPB(o[1]=__builtin_amdgcn_mfma_f32_32x32x16_bf16(PAF(2),VFR(6),o[1],0,0,0), C1,4,w1_); \
    GAPB(o[0]=__builtin_amdgcn_mfma_f32_32x32x16_bf16(PAF(3),VFR(3),o[0],0,0,0), C1,8,w1_); \
    GAPB(o[1]=__builtin_amdgcn_mfma_f32_32x32x16_bf16(PAF(3),VFR(7),o[1],0,0,0), C1,12,w1_); \
    }while(0)
  int t=1;
  #undef CMASK
  #define CMASK(P0,P1,t) do{}while(0)
  for(;t+5<NT;t+=2){
    STEP(pB0,pB1,pA0,pA1,t,true,true,true,true);     WAIT_BAR(2); RESC(); ROT();
    STEP(pA0,pA1,pB0,pB1,t+1,true,true,true,true);   WAIT_BAR(2); RESC(); ROT();
  }
  #undef CMASK
  #define CMASK(P0,P1,t) do{int jb_=(t)-(NT-4); if(jb_>(wid>>1)){_Pragma("unroll") for(int r_=0;r_<16;++r_){P0[r_]=-INFINITY;P1[r_]=-INFINITY;}}}while(0)
  #define ENDW(tt) do{ if((tt)+3<NT){WAIT_BAR(2);} else if((tt)+2<NT){WAIT_BAR(1);} else {WAIT_BAR(0);} }while(0)
  for(;t+1<NT;t+=2){
    STEP(pB0,pB1,pA0,pA1,t,(t+3<NT),(t+1<NT),(t+1<NT),(t+1<NT));       ENDW(t);   RESC(); ROT();
    STEP(pA0,pA1,pB0,pB1,t+1,(t+4<NT),(t+2<NT),(t+2<NT),(t+2<NT));     ENDW(t+1); RESC(); ROT();
  }
  STEP(pB0,pB1,pA0,pA1,NT-1,false,false,false,false); RESC();
  { float sacc=pB0[0]+pB0[1]; _Pragma("unroll") for(int r=2;r<16;++r)sacc+=pB0[r]; _Pragma("unroll") for(int r=0;r<16;++r)sacc+=pB1[r]; l_reg+=sacc;
    pw0=(u32x4){PKW(pB0,0),PKW(pB0,2),PKW(pB0,4),PKW(pB0,6)};pw1=(u32x4){PKW(pB0,8),PKW(pB0,10),PKW(pB0,12),PKW(pB0,14)};pw2=(u32x4){PKW(pB1,0),PKW(pB1,2),PKW(pB1,4),PKW(pB1,6)};pw3=(u32x4){PKW(pB1,8),PKW(pB1,10),PKW(pB1,12),PKW(pB1,14)};
    SBAR(); pv(o,vb0+sl_cur,PAF(0),PAF(1),PAF(2),PAF(3)); }
  #undef PKW
  #undef PAF
  #undef VFR
  #undef PIN
  #undef MX3
  #undef GAPA
  #undef GAPB
  #undef EX
  #undef VRD
  #undef KRD
  #undef STEP
  #undef ENDW
  {auto rr=__builtin_amdgcn_permlane32_swap(__float_as_uint(l_reg),__float_as_uint(l_reg),false,false);l_reg=__uint_as_float(rr[0])+__uint_as_float(rr[1]);}
  if(hi==0)wsf[32+r32]=l_reg;asm volatile("s_waitcnt lgkmcnt(0)":::"memory");
  float rli[16];
  #pragma unroll
  for(int r=0;r<16;++r)rli[r]=__builtin_amdgcn_rcpf(wsf[32+crow(r,hi)]);
  _Float16*Ow=O+(rowbase+q0+wid*QBLK)*OPITCH+h*D;
  { _Float16*stg=(_Float16*)(shm+LDS_OST)+wid*2048;
    #pragma unroll
    for(int r=0;r<16;++r){const int orow=crow(r,hi);
      #pragma unroll
      for(int d0=0;d0<2;++d0)stg[orow*64+d0*32+r32]=(_Float16)(o[d0][r]*rli[r]);}
    asm volatile("s_waitcnt lgkmcnt(0)":::"memory");
    #pragma unroll
    for(int i=0;i<4;++i){const int row=i*8+(lane>>3),ch=lane&7; const u32x4 v=*(const u32x4*)(stg+row*64+ch*8); ATTN_STORE16(Ow+(long)row*OPITCH+ch*8,v);
      typedef _Float16 h8_t __attribute__((ext_vector_type(8))); const h8_t hv=__builtin_bit_cast(h8_t,v); float ss=0.f;
      #pragma unroll
      for(int k=0;k<8;++k){const float f=(float)hv[k]; ss+=f*f;}
      ss+=__shfl_xor(ss,1); ss+=__shfl_xor(ss,2); ss+=__shfl_xor(ss,4);
      if(ch==0)SSQ[(size_t)(rowbase+q0+wid*QBLK+row)*8+h]=ss; } }
  asm volatile("s_waitcnt lgkmcnt(0)\n\ts_barrier":::"memory");
  #undef DMA_K
  #undef DMA_V
  #undef CMASK
  #undef START
  #undef RESC
  #undef ROT
  #undef MLOAD
  #undef MWORDS
  #undef MBIT
  #undef MAND
  #undef MAND0
}
constexpr int ATTN_LDS_BYTES=LDS_BYTES;
struct AttnTensors { const bf16* Q; const bf16* K; const bf16* V; _Float16* O; const unsigned* MASKP; float* SSQ; };
struct AttnUnit { int bh; int qb; };
struct StaticOrder {
  int vcu,G;
  __device__ __forceinline__ explicit StaticOrder(int grid,int block):vcu((grid%8==0)?(block%8)*(grid/8)+block/8:block),G(grid){}
  __device__ __forceinline__ bool next(int i,AttnUnit&u)const{
    if(G==256){ if(i>=8)return false; const int s=vcu&3; u.bh=vcu>>2; const int base=(i>>1)*8; u.qb=(i&1)?base+7-s:base+s; return true; }
    const int L=i*G+vcu; if(L>=BATCH*NHEAD*NQB)return false; u.bh=L/NQB; u.qb=L%NQB; return true; }
};
template<class Sched,int THRL=8> __device__ __forceinline__ void attn_phase(char*lds,const AttnTensors&T,const Sched&S){
  AttnUnit u;
  for(int i=0;S.next(i,u);++i){ attn_unit<THRL>(u.bh/NHEAD,u.bh%NHEAD,u.qb,T.Q,T.K,T.V,T.O,T.MASKP,T.SSQ,lds); }
}
#undef SBAR
#undef WAIT_BAR
}


#ifndef PROBE_DUP
#define PROBE_DUP -1
#endif
#ifndef IDX_STAGGER
#define IDX_STAGGER 6
#endif
#define LDS_WAIT() asm volatile("s_waitcnt lgkmcnt(0)" ::: "memory")

__device__ __forceinline__ void mod_phase(LAS unsigned char* lds, const float* c, const float* w_ada, const float* b_ada, float* mod, int tid, int G) {
    LAS float* sl = (LAS float*)(lds + 69632);
    LAS float* red = (LAS float*)(lds + 102400);
    for (int i = tid; i < 8192; i += 512) { const float v = c[i]; sl[i] = v / (1.f + __expf(-v)); }
    __syncthreads();
    for (int u = blockIdx.x; u < 256; u += G) {
        const int cx = tid % 24, ks = tid / 24; const int col = u * 24 + cx;
        if (ks < 16) {
            float acc[8];
#pragma unroll
            for (int b = 0; b < 8; ++b) acc[b] = 0.f;
#pragma unroll 8
            for (int k = ks * 64; k < ks * 64 + 64; ++k) {
                const float w = w_ada[(size_t)k * 6144 + col];
#pragma unroll
                for (int b = 0; b < 8; ++b) acc[b] += sl[b * 1024 + k] * w;
            }
#pragma unroll
            for (int b = 0; b < 8; ++b) red[(ks * 8 + b) * 24 + cx] = acc[b];
        }
        __syncthreads();
        if (tid < 192) { const int b = tid / 24, c2 = tid % 24; float s = 0.f;
#pragma unroll
          for (int k2 = 0; k2 < 16; ++k2) s += red[(k2 * 8 + b) * 24 + c2];
          mod[b * 6144 + u * 24 + c2] = s + b_ada[u * 24 + c2]; }
        __syncthreads();
    }
}

template <class SrcCol, class KScale>
__device__ __forceinline__ void transpose_item(const float* W, int ldw, int kxor, h16* WT, int ldt, int destrow0, int k0, SrcCol sc, KScale ks, LAS float* scr, int lane) {
    const int n = lane & 31; const int col = sc(destrow0 + n);
#pragma unroll 8
    for (int i = 0; i < 32; ++i) { const int kk = 2 * i + (lane >> 5); const int sk = (k0 + kk) ^ kxor; float v = 0.f; if (col >= 0) v = W[(size_t)sk * ldw + col] * ks(sk); scr[kk * 33 + n] = v; }
    LDS_WAIT(); asm volatile("" ::: "memory");
    const int c = lane & 7;
#pragma unroll
    for (int j = 0; j < 4; ++j) { const int nn = (lane >> 3) + 8 * j; const LAS float* s = scr + (8 * c) * 33 + nn;
        u32x4 o; o.x = pkh(s[0 * 33], s[1 * 33]); o.y = pkh(s[2 * 33], s[3 * 33]); o.z = pkh(s[4 * 33], s[5 * 33]); o.w = pkh(s[6 * 33], s[7 * 33]);
        *(u32x4*)(WT + (size_t)(destrow0 + nn) * ldt + k0 + 8 * c) = o; }
    LDS_WAIT(); asm volatile("" ::: "memory");
}
template <class SrcCol>
__device__ __forceinline__ void transpose_item_f8(const float* W, int ldw, unsigned char* WT, int ldt, int destrow0, int k0, SrcCol sc, float scale, LAS float* scr, int lane) {
    const int n = lane & 31; const int col = sc(destrow0 + n);
#pragma unroll 8
    for (int i = 0; i < 32; ++i) { const int kk = 2 * i + (lane >> 5); scr[kk * 33 + n] = W[(size_t)(k0 + kk) * ldw + col] * scale; }
    LDS_WAIT(); asm volatile("" ::: "memory");
    const int c = lane & 7;
#pragma unroll
    for (int j = 0; j < 4; ++j) { const int nn = (lane >> 3) + 8 * j; const LAS float* s = scr + (8 * c) * 33 + nn;
        u32x2 o; o.x = pk4f8(s[0 * 33], s[1 * 33], s[2 * 33], s[3 * 33]); o.y = pk4f8(s[4 * 33], s[5 * 33], s[6 * 33], s[7 * 33]);
        *(u32x2*)(WT + (size_t)(destrow0 + nn) * ldt + k0 + 8 * c) = o; }
    LDS_WAIT(); asm volatile("" ::: "memory");
}
__device__ __forceinline__ int win_src(int dr) {
    const int pn = dr >> 8, tc = dr & 255, w = tc & 31, wc = (tc >> 5) & 3, bj = tc >> 7;
    if (pn < 4) return pn * 256 + tc;
    if (pn < 8) return (pn < 6 ? 1024 : 1536) + ((pn & 1) * 4 + wc) * 64 + bj * 32 + w;
    if (pn < 12) return 2048 + (pn - 8) * 256 + tc;
    if (wc == 0) return 3072 + bj * 32 + w;
    if (wc == 1 && bj == 0 && w < 8) return 3136 + w;
    return -1;
}
__device__ __forceinline__ void transpose_item_w1(const float* W, unsigned char* WT, int f0, int k0, float scale, LAS float* scr, int lane) {
    const int n = lane & 31;
    f32x2 v[32];
#pragma unroll
    for (int i = 0; i < 32; ++i) { const int kk = 2 * i + (lane >> 5); v[i] = *(const f32x2*)(W + (size_t)(k0 + kk) * 2048 + 2 * (f0 + n)); }
    const int drow = 256 * (f0 >> 7) + (f0 & 127);
#pragma unroll
    for (int par = 0; par < 2; ++par) {
#pragma unroll
        for (int i = 0; i < 32; ++i) { const int kk = 2 * i + (lane >> 5); scr[kk * 33 + n] = v[i][par] * scale; }
        LDS_WAIT(); asm volatile("" ::: "memory");
        const int c = lane & 7;
#pragma unroll
        for (int j = 0; j < 4; ++j) { const int nn = (lane >> 3) + 8 * j; const LAS float* s = scr + (8 * c) * 33 + nn;
            u32x2 o; o.x = pk4f8(s[0 * 33], s[1 * 33], s[2 * 33], s[3 * 33]); o.y = pk4f8(s[4 * 33], s[5 * 33], s[6 * 33], s[7 * 33]);
            *(u32x2*)(WT + (size_t)(drow + 128 * par + nn) * 1024 + k0 + 8 * c) = o; }
        LDS_WAIT(); asm volatile("" ::: "memory");
    }
}
struct P0Args { const float *w_in, *w_out, *rg_g, *at_g, *w1, *w2, *w_router, *w_rg_a, *w_rg_x; h16 *WIN, *WOUT; unsigned char *W1, *W2; h16 *WROUT, *WRG; };
__device__ __forceinline__ void convert_phase(LAS unsigned char* lds, const P0Args& a, int tid, int lane, int wave, int first, int stride, int big) {
    LAS float* scr = (LAS float*)(lds + wave * 8448);
    constexpr int I_IN = 104 * 16, I_OUT = 32 * 16, I_1 = 32 * 32 * 16, I_2 = 32 * 32 * 16, I_R = 16;
    constexpr int NITEMS = I_IN + I_OUT + I_1 + I_2 + I_R;
    auto one = [](int) { return 1.f; };
    constexpr int NSMALL = I_IN + I_OUT + I_R, NBIG = I_1 + I_2; static_assert(NSMALL + NBIG == NITEMS, "items");
    const int nit = big ? NBIG : NSMALL;
    for (int it = first; it < nit; it += stride) {
        int r = big ? it + I_IN + I_OUT : (it < I_IN + I_OUT ? it : it + NBIG);
        if (r < I_IN) { transpose_item(a.w_in, DIN, 0, a.WIN, 1024, (r >> 4) * 32, (r & 15) * 64, [](int dr) { return win_src(dr); }, one, scr, lane); continue; } r -= I_IN;
        if (r < I_OUT) { const float* rg = a.rg_g; const float* ag = a.at_g;
            transpose_item(a.w_out, 1024, 512, a.WOUT, 1024, (r >> 4) * 32, (r & 15) * 64, [](int dr) { return dr; }, [rg, ag](int sk) { return sk < 512 ? rg[sk] : ag[sk - 512]; }, scr, lane); continue; } r -= I_OUT;
        if (r < I_1) { const int e = r >> 9, q = r & 511;
            transpose_item_w1(a.w1 + (size_t)e * 1024 * 2048, a.W1 + (size_t)e * 2048 * 1024, (q >> 4) * 32, (q & 15) * 64, W1_F8_SCALE, scr, lane); continue; } r -= I_1;
        if (r < I_2) { const int e = r >> 9, q = r & 511;
            transpose_item_f8(a.w2 + (size_t)e * 1024 * 1024, 1024, a.W2 + (size_t)e * 1024 * 1024, 1024, (q >> 4) * 32, (q & 15) * 64, [](int dr) { return dr; }, W2_F8_SCALE, scr, lane); continue; } r -= I_2;
        transpose_item(a.w_router, 32, 0, a.WROUT, 1024, (r >> 4) * 32, (r & 15) * 64, [](int dr) { return dr < 32 ? dr : -1; }, one, scr, lane);
    }
    if (!big && (int)blockIdx.x < 8) {
        const int hb = blockIdx.x;
        for (int i = tid; i < 128 * 64; i += 512) { const int rr = i >> 6, k = i & 63, p = rr >> 5, gate = (rr >> 4) & 1, cc = rr & 15;
            const float* src = gate ? a.w_rg_x : a.w_rg_a; a.WRG[(size_t)hb * 8192 + i] = (h16)src[(size_t)hb * 4096 + k * 64 + 16 * p + cc]; }
    }
}

__device__ __forceinline__ void rmsnorm_rows(const float* src, h16* dst, unsigned char* dst8, const float* gain, const float* sc, const float* sh, int gw, int NGW, int lane) {
    for (int chunk = gw; chunk < T / 32; chunk += NGW) {
        const int row0 = chunk * 32, b = row0 >> 13;
        f32x4 scale[4], shift[4];
#pragma unroll
        for (int j = 0; j < 4; ++j) { const int k = 4 * lane + 256 * j; const f32x4 g = *(const f32x4*)(gain + k), s1 = *(const f32x4*)(sc + b * 6144 + k); scale[j] = g * (1.f + s1); shift[j] = *(const f32x4*)(sh + b * 6144 + k); }
        for (int r = 0; r < 32; ++r) {
            const size_t ro = (size_t)(row0 + r) * 1024 + 4 * lane;
            f32x4 v[4]; float ss = 0.f;
#pragma unroll
            for (int j = 0; j < 4; ++j) { v[j] = *(const f32x4*)(src + ro + 256 * j); ss += (v[j][0] * v[j][0] + v[j][1] * v[j][1]) + (v[j][2] * v[j][2] + v[j][3] * v[j][3]); }
            const float rs = rsqrtf(wave_sum(ss) * (1.f / 1024.f) + EPS);
#pragma unroll
            for (int j = 0; j < 4; ++j) { const f32x4 y = v[j] * rs * scale[j] + shift[j]; u32x2 o; o.x = pkh(y[0], y[1]); o.y = pkh(y[2], y[3]); *(u32x2*)(dst + ro + 256 * j) = o;
                if (dst8) *(unsigned*)(dst8 + ro + 256 * j) = pk4f8(y[0], y[1], y[2], y[3]); }
        }
    }
}

__device__ __forceinline__ void rg_phase(LAS unsigned char* lds, const h16* XR, const float* conv_w, const float* conv_b, const h16* WRG, const float* b_a, const float* b_x, const float* lam,
                                         h16* HL, h16* AC, float* SUMP, float* SUMH, int tid, int lane, int wave, int G) {
    constexpr int XCS = 520;
    LAS h16* xc = (LAS h16*)lds;
    LAS h16* stg = (LAS h16*)(lds + 66560) + wave * 2048;
    const int cl = lane & 15, q = lane >> 4;
    if ((int)blockIdx.x >= 1024) return;
    f16x8 Bg[8][2];
#pragma unroll
    for (int nt = 0; nt < 8; ++nt)
#pragma unroll
        for (int ks = 0; ks < 2; ++ks) Bg[nt][ks] = *(const f16x8*)(WRG + ((size_t)(wave * 128 + nt * 16 + cl) * 64 + ks * 32 + q * 8));
    float ba[4], bx[4], sp[4];
#pragma unroll
    for (int p = 0; p < 4; ++p) { const int ch = wave * 64 + 16 * p + cl; ba[p] = b_a[ch]; bx[p] = b_x[ch]; const float nl = -lam[ch]; sp[p] = nl > 20.f ? nl : log1pf(__expf(nl)); }
    const int co = tid & 63;
    float cw[4][8], cb[8];
#pragma unroll
    for (int j = 0; j < 4; ++j) { const f32x4 a0 = *(const f32x4*)(conv_w + j * 512 + 8 * co), a1 = *(const f32x4*)(conv_w + j * 512 + 8 * co + 4);
#pragma unroll
        for (int k = 0; k < 4; ++k) { cw[j][k] = a0[k]; cw[j][4 + k] = a1[k]; } }
    { const f32x4 a0 = *(const f32x4*)(conv_b + 8 * co), a1 = *(const f32x4*)(conv_b + 8 * co + 4);
#pragma unroll
      for (int k = 0; k < 4; ++k) { cb[k] = a0[k]; cb[4 + k] = a1[k]; } }
    for (int u = blockIdx.x; u < 1024; u += G) {
        const int b = u >> 7, chn = u & 127, s0 = chn * 64; const size_t t0 = (size_t)b * 8192 + s0;
        {
            f16x8 xin[11];
#pragma unroll
            for (int i = 0; i < 11; ++i) { const int s = s0 + 8 * wave - 3 + i; f16x8 z = {0, 0, 0, 0, 0, 0, 0, 0}; xin[i] = (s >= 0) ? *(const f16x8*)(XR + ((size_t)b * 8192 + s) * 512 + 8 * co) : z; }
#pragma unroll
            for (int i = 0; i < 8; ++i) {
                float o[8];
#pragma unroll
                for (int k = 0; k < 8; ++k) { float a = cb[k];
#pragma unroll
                    for (int j = 0; j < 4; ++j) a += cw[j][k] * (float)xin[i + j][k];
                    o[k] = a; }
                u32x4 w; w.x = pkh(o[0], o[1]); w.y = pkh(o[2], o[3]); w.z = pkh(o[4], o[5]); w.w = pkh(o[6], o[7]);
                *(LAS u32x4*)(xc + (8 * wave + i) * XCS + 8 * co) = w;
            }
        }
        __syncthreads();
        float Pm[4], Hm[4];
#pragma unroll
        for (int p = 0; p < 4; ++p) { Pm[p] = 1.f; Hm[p] = 0.f; }
#pragma unroll 1
        for (int mt = 0; mt < 4; ++mt) {
            f16x8 Af[2];
#pragma unroll
            for (int ks = 0; ks < 2; ++ks) Af[ks] = *(const LAS f16x8*)(xc + (mt * 16 + cl) * XCS + wave * 64 + ks * 32 + q * 8);
#pragma unroll
            for (int p = 0; p < 4; ++p) {
                f32x4 ca = {0.f, 0.f, 0.f, 0.f}, cx = {0.f, 0.f, 0.f, 0.f};
#pragma unroll
                for (int ks = 0; ks < 2; ++ks) { ca = __builtin_amdgcn_mfma_f32_16x16x32_f16(Af[ks], Bg[2 * p][ks], ca, 0, 0, 0); cx = __builtin_amdgcn_mfma_f32_16x16x32_f16(Af[ks], Bg[2 * p + 1][ks], cx, 0, 0, 0); }
                float a[4], uu[4];
#pragma unroll
                for (int j = 0; j < 4; ++j) {
                    const float xcv = (float)xc[(mt * 16 + 4 * q + j) * XCS + wave * 64 + 16 * p + cl];
                    const float ra = sigmoidf_(ca[j] + ba[p]), ix = sigmoidf_(cx[j] + bx[p]);
                    const float la = -8.f * ra * sp[p];
                    a[j] = __expf(la);
                    const float x2 = 2.f * la, ser = -x2 * __builtin_fmaf(x2, __builtin_fmaf(x2, __builtin_fmaf(x2, 1.f / 24.f, 1.f / 6.f), 0.5f), 1.f);
                    const float om = x2 > -0.125f ? ser : __builtin_fmaf(-a[j], a[j], 1.f);
                    uu[j] = __builtin_amdgcn_sqrtf(fmaxf(om, 0.f)) * ix * xcv;
                }
                float iA = a[0] * a[1] * a[2] * a[3], iH = ((uu[0] * a[1] + uu[1]) * a[2] + uu[2]) * a[3] + uu[3];
                float tA = __shfl_up(iA, 16), tH = __shfl_up(iH, 16); if (q >= 1) { iH = iA * tH + iH; iA = tA * iA; }
                tA = __shfl_up(iA, 32); tH = __shfl_up(iH, 32); if (q >= 2) { iH = iA * tH + iH; iA = tA * iA; }
                float eA = __shfl_up(iA, 16), eH = __shfl_up(iH, 16); if (q == 0) { eA = 1.f; eH = 0.f; }
                const float totA = __shfl(iA, 48 + cl), totH = __shfl(iH, 48 + cl);
                float Pg = Pm[p] * eA, Hg = eA * Hm[p] + eH;
#pragma unroll
                for (int j = 0; j < 4; ++j) { Hg = a[j] * Hg + uu[j]; Pg *= a[j]; stg[(4 * q + j) * 64 + 16 * p + cl] = (h16)Hg; stg[1024 + (4 * q + j) * 64 + 16 * p + cl] = (h16)Pg; }
                Hm[p] = totA * Hm[p] + totH; Pm[p] = Pm[p] * totA;
            }
            LDS_WAIT(); asm volatile("" ::: "memory");
#pragma unroll
            for (int it = 0; it < 2; ++it) { const int idx = lane + 64 * it, r = idx >> 3, c8 = idx & 7; const size_t go = (t0 + mt * 16 + r) * 512 + wave * 64 + c8 * 8;
                *(u32x4*)(HL + go) = *(const LAS u32x4*)(stg + r * 64 + c8 * 8); *(u32x4*)(AC + go) = *(const LAS u32x4*)(stg + 1024 + r * 64 + c8 * 8); }
            LDS_WAIT(); asm volatile("" ::: "memory");
        }
        if (q == 0) {
#pragma unroll
            for (int p = 0; p < 4; ++p) { const size_t so = ((size_t)b * 128 + chn) * 512 + wave * 64 + 16 * p + cl; SUMP[so] = Pm[p]; SUMH[so] = Hm[p]; }
        }
        __syncthreads();
    }
}

__device__ __forceinline__ void r3_phase(LAS unsigned char* lds, const h16* HL, const h16* AC, const h16* XG, const float* SUMP, const float* SUMH, h16* MIX, int tid, int lane, int wave, int G) {
    LAS float* carry = (LAS float*)lds;
    for (int u = blockIdx.x; u < 1024; u += G) {
        const int b = u >> 7, chn = u & 127;
        { float cr = 0.f; const float* sp = SUMP + (size_t)b * 128 * 512 + tid; const float* sh = SUMH + (size_t)b * 128 * 512 + tid;
          int c2 = 0;
          for (; c2 + 8 <= chn; c2 += 8) { float pv[8], hv[8];
#pragma unroll
              for (int k = 0; k < 8; ++k) { pv[k] = sp[(size_t)(c2 + k) * 512]; hv[k] = sh[(size_t)(c2 + k) * 512]; }
#pragma unroll
              for (int k = 0; k < 8; ++k) cr = pv[k] * cr + hv[k]; }
          for (; c2 < chn; ++c2) cr = sp[(size_t)c2 * 512] * cr + sh[(size_t)c2 * 512];
          carry[tid] = cr; }
        __syncthreads();
        const f32x4 c0 = *(const LAS f32x4*)(carry + 8 * lane), c1 = *(const LAS f32x4*)(carry + 8 * lane + 4);
        float cv[8] = {c0[0], c0[1], c0[2], c0[3], c1[0], c1[1], c1[2], c1[3]};
#pragma unroll 2
        for (int i = 0; i < 8; ++i) {
            const size_t t = (size_t)b * 8192 + chn * 64 + wave * 8 + i; const size_t off = t * 512 + 8 * lane;
            const f16x8 hl = *(const f16x8*)(HL + off), ac = *(const f16x8*)(AC + off), xg = *(const f16x8*)(XG + off);
            float y[8], ss = 0.f;
#pragma unroll
            for (int k = 0; k < 8; ++k) { const float x = (float)xg[k]; const float z = 0.7978845608028654f * (x + 0.044715f * x * x * x); const float th = 1.f - 2.f / (__expf(2.f * z) + 1.f);
                y[k] = 0.5f * x * (1.f + th) * ((float)hl[k] + (float)ac[k] * cv[k]); ss += y[k] * y[k]; }
            const float rs = rsqrtf(wave_sum(ss) * (1.f / 512.f) + EPS);
            u32x4 w; w.x = pkh(y[0] * rs, y[1] * rs); w.y = pkh(y[2] * rs, y[3] * rs); w.z = pkh(y[4] * rs, y[5] * rs); w.w = pkh(y[6] * rs, y[7] * rs);
            *(u32x4*)(MIX + t * 1024 + 512 + 8 * lane) = w;
        }
        __syncthreads();
    }
}

__device__ __forceinline__ int idx_bin(float sc) {
    const unsigned u = __float_as_uint(sc);
    int v = (int)((u << 1) >> 20) - (114 << 4);
    v = v < 0 ? 0 : (v > 255 ? 255 : v);
    const unsigned sg = (unsigned)((int)u >> 31);
    return (int)((unsigned)v ^ 0x100u ^ (sg & 0x1ffu));
}
__device__ __forceinline__ float idx_edge(int b) {
    if (b >= 512) return INFINITY;
    if (b <= 0) return -INFINITY;
    if (b >= 256) { const int v = b - 256; return v == 0 ? 0.f : __uint_as_float((unsigned)(v + 1824) << 19); }
    const int v = 255 - b; return -__uint_as_float(((unsigned)(v + 1825) << 19) - 1u);
}
__device__ __forceinline__ float fma_np(float a, float b, float c) { float r; asm("v_fma_f32 %0, %1, %2, %3" : "=v"(r) : "v"(a), "v"(b), "v"(c)); return r; }
__device__ __forceinline__ float relu_i(float x) { const int i = __float_as_int(x); return __int_as_float(i > 0 ? i : 0); }
__device__ __forceinline__ void idx_glds16(const void* gsrc, unsigned lds_dst) { unsigned keep;
    asm volatile("s_mov_b32 %0, m0\n\ts_mov_b32 m0, %2\n\ts_nop 0\n\tglobal_load_lds_dwordx4 %1, off\n\ts_mov_b32 m0, %0" : "=&s"(keep) : "v"(gsrc), "s"(lds_dst) : "memory"); }
__device__ __forceinline__ float fma_wlo(float a, unsigned w, float c) { float r; asm("v_fma_mix_f32 %0, %1, %2, %3 op_sel:[0,0,0] op_sel_hi:[0,1,0]" : "=v"(r) : "v"(a), "v"(w), "v"(c)); return r; }
__device__ __forceinline__ float fma_whi(float a, unsigned w, float c) { float r; asm("v_fma_mix_f32 %0, %1, %2, %3 op_sel:[0,1,0] op_sel_hi:[0,1,0]" : "=v"(r) : "v"(a), "v"(w), "v"(c)); return r; }
__device__ __forceinline__ unsigned idx_binoff(float sc) {
    const int u = __float_as_int(sc);
    int v = (int)__builtin_amdgcn_ubfe((unsigned)u, 19, 12) - (114 << 4);
    v = v < 0 ? 0 : (v > 255 ? 255 : v);
    return (unsigned)(v ^ ((u >> 31) & 0x1ff) ^ 0x100) << 2;
}
__device__ __forceinline__ void idx_phase(LAS unsigned char* lds, const h16* QI, const h16* KI, const float* WI, unsigned* MASK, unsigned char* SCR, int tid, int lane, int wave, int G) {
    LAS unsigned* hist = (LAS unsigned*)lds;
    LAS unsigned* maskq = (LAS unsigned*)(lds + 65536);
    LAS int* bstar = (LAS int*)(lds + 131072); LAS int* cabove = bstar + 32; LAS unsigned* ccount = (LAS unsigned*)(bstar + 64);
    LAS float* wtab = (LAS float*)(lds + 131072 + 512);
    LAS float* thr = (LAS float*)(lds + 131072 + 1536);
    LAS unsigned* cnt6 = (LAS unsigned*)(lds + 98304);
    LAS unsigned* vsel = (LAS unsigned*)(lds + 131072 + 1536 + 512);
    const int qh = wave >> 2, kq = wave & 3, n32 = lane & 31, half = lane >> 5;
    unsigned char* scr = SCR + (size_t)blockIdx.x * (512u << 10) + (size_t)qh * 1024 + lane * 16;
    for (int U = blockIdx.x; U < 2048; U += G) {
        const int b = U >> 8, cc = U & 255, ub = (b & 1) ? 255 - cc : cc;
        const size_t t0 = (size_t)b * 8192 + ub * 32; const int nadm = 64 * ((ub >> 1) + 1), nkt = nadm >> 5;
        if (nadm <= TOPK) {
            for (int i = tid; i < 32 * nkt; i += 512) { const int tok = i / nkt, kt = i % nkt; MASK[(t0 + tok) * 256 + kt] = 0xffffffffu; }
            continue;
        }
#pragma unroll
        for (int i = 0; i < 8; ++i) ((LAS u32x4*)hist)[tid + 512 * i] = (u32x4){0u, 0u, 0u, 0u};
        if (tid < 32) ccount[tid] = 0u;
        *(LAS u32x4*)(cnt6 + 4 * tid) = (u32x4){0u, 0u, 0u, 0u};
        if (tid < 256) wtab[tid] = WI[t0 * 8 + tid] * IDX_WSCALE;
        f16x8 Aq[4][4];
        { const int r = lane & 31, tt = 2 * (r >> 4) + ((r >> 2) & 1), hd = (r & 3) + 4 * ((r >> 3) & 1);
#pragma unroll
          for (int j = 0; j < 4; ++j)
#pragma unroll
              for (int s = 0; s < 4; ++s) Aq[j][s] = *(const f16x8*)(QI + (t0 + 16 * qh + 4 * j + tt) * 512 + hd * 64 + 16 * s + 8 * half);
        }
#pragma unroll
        for (int j = 0; j < 4; ++j)
#pragma unroll
            for (int s2 = 0; s2 < 4; ++s2) asm volatile("" : "+v"(Aq[j][s2]));
        asm volatile("s_waitcnt vmcnt(0)" ::: "memory");
        __syncthreads();
        const h16* kp = KI + (size_t)b * 8192 * 64 + n32 * 64 + 8 * half;
        const int tokl0 = 16 * qh + half;
        unsigned W16[8][4];
#pragma unroll
        for (int ii = 0; ii < 8; ++ii) { const LAS f32x4* wp_ = (const LAS f32x4*)(wtab + (tokl0 + 2 * ii) * 8); const f32x4 w0 = wp_[0], w1 = wp_[1];
            W16[ii][0] = pkh(w0[0], w0[1]); W16[ii][1] = pkh(w0[2], w0[3]); W16[ii][2] = pkh(w1[0], w1[1]); W16[ii][3] = pkh(w1[2], w1[3]); }
        const f32x16 zero16 = {0.f, 0.f, 0.f, 0.f, 0.f, 0.f, 0.f, 0.f, 0.f, 0.f, 0.f, 0.f, 0.f, 0.f, 0.f, 0.f};
        const int ktl = kq + 4 * ((nkt - 1 - kq) >> 2);
#define IDX_LOADB(DST, KT) do { _Pragma("unroll") for (int s2 = 0; s2 < 4; ++s2) DST[s2] = *(const f16x8*)(kp + (size_t)((KT) <= ktl ? (KT) : ktl) * 2048 + 16 * s2); } while (0)
#define IDX_SB __builtin_amdgcn_sched_barrier(0)
#define IDX_MF(ACC, J, K, BK_) ACC = __builtin_amdgcn_mfma_f32_32x32x16_f16(Aq[J][K], BK_[K], (K) == 0 ? zero16 : ACC, 0, 0, 0)
#define IDX_Q(ACC, II, BP, HF) do { s0 = fma_wlo(relu_i(ACC[8 * (BP) + 4 * (HF) + 0]), W16[II][2 * (HF)], s0); s1 = fma_whi(relu_i(ACC[8 * (BP) + 4 * (HF) + 1]), W16[II][2 * (HF)], s1); \
        s0 = fma_wlo(relu_i(ACC[8 * (BP) + 4 * (HF) + 2]), W16[II][2 * (HF) + 1], s0); s1 = fma_whi(relu_i(ACC[8 * (BP) + 4 * (HF) + 3]), W16[II][2 * (HF) + 1], s1); } while (0)
#define IDX_STEP(CUR, J, NXT, JN, BN_) do { float s0 = 0.f, s1 = 0.f; \
        IDX_MF(NXT, JN, 0, BN_); IDX_SB; IDX_Q(CUR, 2 * (J), 0, 0); IDX_SB; IDX_MF(NXT, JN, 1, BN_); IDX_SB; \
        IDX_Q(CUR, 2 * (J), 0, 1); sc[2 * (J)] = s0 + s1; s0 = 0.f; s1 = 0.f; IDX_SB; IDX_MF(NXT, JN, 2, BN_); IDX_SB; \
        IDX_Q(CUR, 2 * (J) + 1, 1, 0); IDX_SB; IDX_MF(NXT, JN, 3, BN_); IDX_SB; \
        IDX_Q(CUR, 2 * (J) + 1, 1, 1); sc[2 * (J) + 1] = s0 + s1; IDX_SB; } while (0)
#define IDX_TILE(KT_, BC_, BN_) do { IDX_STEP(accA, 0, accB, 1, BC_); IDX_STEP(accB, 1, accA, 2, BC_); IDX_STEP(accA, 2, accB, 3, BC_); IDX_STEP(accB, 3, accA, 0, BN_); IDX_LOADB(BC_, (KT_) + 8); } while (0)
        f16x8 B0[4], B1[4];
        {
            IDX_LOADB(B0, kq); IDX_LOADB(B1, kq + 4);
            if (wave >= 4) __builtin_amdgcn_s_sleep(IDX_STAGGER);
            f32x16 accA, accB;
            IDX_MF(accA, 0, 0, B0); IDX_MF(accA, 0, 1, B0); IDX_MF(accA, 0, 2, B0); IDX_MF(accA, 0, 3, B0);
            LAS unsigned char* hb = (LAS unsigned char*)hist + tokl0 * 2048;
#define IDX_HIST(KT_) do { unsigned pk_[4]; float sr_[8]; \
        _Pragma("unroll") for (int i = 0; i < 4; ++i) pk_[i] = pkh(sc[2 * i], sc[2 * i + 1]); \
        _Pragma("unroll") for (int i = 0; i < 4; ++i) { const f16x2 p_ = __builtin_bit_cast(f16x2, pk_[i]); sr_[2 * i] = (float)p_[0]; sr_[2 * i + 1] = (float)p_[1]; } \
        { u32x4 w_; w_.x = pk_[0]; w_.y = pk_[1]; w_.z = pk_[2]; w_.w = pk_[3]; *(u32x4*)(scr + (size_t)(KT_) * 2048) = w_; } \
        _Pragma("unroll") for (int q = 0; q < 8; ++q) \
        __hip_atomic_fetch_add((LAS unsigned*)(hb + 4096 * q + idx_binoff(sr_[q])), 1u, __ATOMIC_RELAXED, __HIP_MEMORY_SCOPE_WORKGROUP); } while (0)
#pragma unroll 1
            for (int kt = kq; kt < nkt; kt += 8) {
                float sc[8];
                IDX_TILE(kt, B0, B1); IDX_HIST(kt);
                if (kt + 4 >= nkt) break;
                IDX_TILE(kt + 4, B1, B0); IDX_HIST(kt + 4);
            }
            asm volatile("" :: "v"(accA));
#undef IDX_HIST
            asm volatile("s_waitcnt vmcnt(0)" ::: "memory");
        }
        __syncthreads();
        {
            const int tok = tid >> 4, sub = tid & 15; const LAS unsigned* hrow = hist + tok * 512;
            unsigned s = 0;
#pragma unroll
            for (int w = 0; w < 8; ++w) { const u32x4 x = *(const LAS u32x4*)(hrow + 32 * sub + 4 * w); s += (x.x + x.y) + (x.z + x.w); }
            unsigned v = s;
#pragma unroll
            for (int d = 1; d < 16; d <<= 1) { const unsigned t = __shfl_down(v, d, 16); if (sub + d < 16) v += t; }
            const unsigned above = v - s;
            if (above < (unsigned)TOPK && v >= (unsigned)TOPK) {
                unsigned cum = above;
                for (int bin = 32 * sub + 31; bin >= 32 * sub; --bin) { const unsigned c = hrow[bin];
                    if (cum + c >= (unsigned)TOPK) { bstar[tok] = bin; cabove[tok] = (int)cum; thr[2 * tok] = idx_edge(bin); thr[2 * tok + 1] = idx_edge(bin + 1); break; } cum += c; }
            }
        }
        __syncthreads();
        {
#define IDX_CLASS(KT_) do { unsigned long long anyc = 0ull; unsigned mlo = 0u, mhi = 0u; unsigned long long bal[8]; \
        _Pragma("unroll") for (int q = 0; q < 8; ++q) { bal[q] = __ballot(sc[q] >= thi[q]); anyc |= __ballot(sc[q] >= tlo[q]) & ~bal[q]; } \
          \
        asm volatile("s_nop 3\n\t" "v_writelane_b32 %0, %2, 0\n\tv_writelane_b32 %0, %3, 1\n\tv_writelane_b32 %0, %4, 2\n\tv_writelane_b32 %0, %5, 3\n\tv_writelane_b32 %0, %6, 4\n\tv_writelane_b32 %0, %7, 5\n\tv_writelane_b32 %0, %8, 6\n\tv_writelane_b32 %0, %9, 7\n\t" \
                     "v_writelane_b32 %1, %10, 0\n\tv_writelane_b32 %1, %11, 1\n\tv_writelane_b32 %1, %12, 2\n\tv_writelane_b32 %1, %13, 3\n\tv_writelane_b32 %1, %14, 4\n\tv_writelane_b32 %1, %15, 5\n\tv_writelane_b32 %1, %16, 6\n\tv_writelane_b32 %1, %17, 7" \
                     : "+v"(mlo), "+v"(mhi) : "s"((unsigned)bal[0]), "s"((unsigned)bal[1]), "s"((unsigned)bal[2]), "s"((unsigned)bal[3]), "s"((unsigned)bal[4]), "s"((unsigned)bal[5]), "s"((unsigned)bal[6]), "s"((unsigned)bal[7]), \
                       "s"((unsigned)(bal[0] >> 32)), "s"((unsigned)(bal[1] >> 32)), "s"((unsigned)(bal[2] >> 32)), "s"((unsigned)(bal[3] >> 32)), "s"((unsigned)(bal[4] >> 32)), "s"((unsigned)(bal[5] >> 32)), "s"((unsigned)(bal[6] >> 32)), "s"((unsigned)(bal[7] >> 32))); \
        if (lane < 8) { maskq[(16 * qh + 2 * lane) * 256 + (KT_)] = mlo; maskq[(16 * qh + 2 * lane + 1) * 256 + (KT_)] = mhi; }     \
        if (anyc) { _Pragma("unroll") for (int q = 0; q < 8; ++q) { if (sc[q] >= tlo[q] && !(sc[q] >= thi[q])) { const int tokl = tokl0 + 2 * q; \
            const unsigned ci = __hip_atomic_fetch_add(&ccount[tokl], 1u, __ATOMIC_RELAXED, __HIP_MEMORY_SCOPE_WORKGROUP); \
            if (ci < 256u) ((LAS u32x2*)hist)[tokl * 256 + ci] = (u32x2){__float_as_uint(sc[q]), (unsigned)(32 * (KT_) + n32)}; } } } } while (0)
            float tlo[8], thi[8];
#pragma unroll
            for (int q = 0; q < 8; ++q) { const f32x2 e_ = *(const LAS f32x2*)(thr + 2 * (tokl0 + 2 * q)); tlo[q] = e_[0]; thi[q] = e_[1]; }
            u32x4 wc_ = *(const u32x4*)(scr + (size_t)kq * 2048);
#pragma unroll 1
            for (int kt = kq; kt < nkt; kt += 4) {
                const u32x4 wn_ = *(const u32x4*)(scr + (size_t)(kt + 4 <= ktl ? kt + 4 : ktl) * 2048);
                unsigned pk_[4] = {wc_.x, wc_.y, wc_.z, wc_.w}; float sc[8];
#pragma unroll
                for (int i = 0; i < 4; ++i) { const f16x2 p_ = __builtin_bit_cast(f16x2, pk_[i]); sc[2 * i] = (float)p_[0]; sc[2 * i + 1] = (float)p_[1]; }
                IDX_CLASS(kt);
                wc_ = wn_;
            }
#undef IDX_CLASS
        }
        __syncthreads();
#undef IDX_TILE
#undef IDX_STEP
#undef IDX_Q
#undef IDX_MF
#undef IDX_SB
#undef IDX_LOADB
        {
            const int tok = tid >> 4, sub = tid & 15; const unsigned m0 = ccount[tok]; const int m = m0 < 256u ? (int)m0 : 256; const int r = TOPK - cabove[tok];
            const LAS u32x2* cd = (const LAS u32x2*)hist + tok * 256;
            const int bs = bstar[tok];
            if (bs == 0 || bs == 255 || bs == 256 || bs == 511) {
                for (int i = sub; i < m; i += 16) { const u32x2 ci = cd[i]; const float si = __uint_as_float(ci.x); int rank = 0;
                    for (int j2 = 0; j2 < m; ++j2) { const u32x2 cj = cd[j2]; const float sj = __uint_as_float(cj.x); rank += (sj > si || (sj == si && cj.y < ci.y)) ? 1 : 0; }
                    if (rank < r) __hip_atomic_fetch_or(&maskq[tok * 256 + (ci.y >> 5)], 1u << (ci.y & 31u), __ATOMIC_RELAXED, __HIP_MEMORY_SCOPE_WORKGROUP); }
            } else {
                LAS unsigned* c6 = cnt6 + tok * 64; const unsigned flip = bs < 256 ? 63u : 0u;
                if (sub == 0) vsel[tok] = 0u;
                for (int i = sub; i < m; i += 16) __hip_atomic_fetch_add(&c6[((cd[i].x >> 13) & 63u) ^ flip], 1u, __ATOMIC_RELAXED, __HIP_MEMORY_SCOPE_WORKGROUP);
                __builtin_amdgcn_fence(__ATOMIC_ACQ_REL, "workgroup");
                const u32x4 x = *(const LAS u32x4*)(c6 + 4 * sub);
                const unsigned s4 = (x.x + x.y) + (x.z + x.w); unsigned v_ = s4;
#pragma unroll
                for (int d = 1; d < 16; d <<= 1) { const unsigned t = __shfl_down(v_, d, 16); if (sub + d < 16) v_ += t; }
                const unsigned above = v_ - s4;
                if (above < (unsigned)r && v_ >= (unsigned)r) {
                    unsigned cum = above; int vst = 4 * sub + 3;
                    if (cum + x.w < (unsigned)r) { cum += x.w; vst = 4 * sub + 2; if (cum + x.z < (unsigned)r) { cum += x.z; vst = 4 * sub + 1; if (cum + x.y < (unsigned)r) { cum += x.y; vst = 4 * sub; } } }
                    vsel[tok] = (unsigned)(vst + 1) | (cum << 8);
                }
                __builtin_amdgcn_fence(__ATOMIC_ACQ_REL, "workgroup");
                const unsigned vs = vsel[tok]; const int vstar = (int)(vs & 0xffu) - 1, need2 = r - (int)(vs >> 8);
                for (int i = sub; i < m; i += 16) { const u32x2 ci = cd[i]; const int k6 = (int)(((ci.x >> 13) & 63u) ^ flip); bool sel = k6 > vstar;
                    if (k6 == vstar) { int rank = 0;
                        for (int j2 = 0; j2 < m; ++j2) { const u32x2 cj = cd[j2]; rank += ((int)(((cj.x >> 13) & 63u) ^ flip) == vstar && cj.y < ci.y) ? 1 : 0; }
                        sel = rank < need2; }
                    if (sel) __hip_atomic_fetch_or(&maskq[tok * 256 + (ci.y >> 5)], 1u << (ci.y & 31u), __ATOMIC_RELAXED, __HIP_MEMORY_SCOPE_WORKGROUP); }
#pragma unroll
                for (int k = 0; k < 4; ++k) c6[4 * sub + k] = 0u;
            }
        }
        __syncthreads();
        for (int i = tid; i < 32 * nkt; i += 512) { const int tok = i / nkt, kt = i % nkt; MASK[(t0 + tok) * 256 + kt] = maskq[tok * 256 + kt]; }
        asm volatile("s_waitcnt vmcnt(0)" ::: "memory");
        __syncthreads();
    }
}

__device__ __forceinline__ void norm_route_phase(LAS unsigned char* lds, const float* x1, unsigned char* H8, const float* gain, const float* sc, const float* sh,
        const h16* WR, const float* b_router, unsigned* CNT, u64* ROWINFO, unsigned* TOKSLOT, int tid, int lane, int wave, int G, int vcu) {
    constexpr int WPITCH = 2064;
    LAS unsigned char* wl = lds;
    LAS float* mod = (LAS float*)(lds + 66048);
    LAS float* lgt = (LAS float*)(lds + 74240);
    LAS unsigned* hist = (LAS unsigned*)(lds + 108032); LAS unsigned* base = hist + 128;
    const int fr = lane & 15, fq = lane >> 4;
    for (int i = tid; i < 32 * 128; i += 512) { const int n = i >> 7, c = i & 127; *(LAS u32x4*)(wl + n * WPITCH + c * 16) = *(const u32x4*)(WR + n * 1024 + c * 8); }
    for (int t0 = vcu * 256; t0 < T; t0 += G * 256) {
        const int b = t0 >> 13;
        __syncthreads();
        for (int k = tid; k < 1024; k += 512) { mod[k] = gain[k] * (1.f + sc[b * 6144 + k]); mod[1024 + k] = sh[b * 6144 + k]; }
        if (tid < 32) hist[tid] = 0u;
        __syncthreads();
#pragma unroll 1
        for (int g_ = 0; g_ < (PROBE_DUP == 6 ? 4 : 2); ++g_) { const int g = g_ & 1;
            const int lrow = wave * 32 + g * 16;
            const h16* xp = (const h16*)x1 + (size_t)(t0 + lrow + fr) * 2048 + 1024 + 16 * fq;
            unsigned xa[16][8]; float ss = 0.f, ss2 = 0.f;
#pragma unroll
            for (int kk = 0; kk < 16; ++kk) {
                const u32x4 v0 = *(const u32x4*)(xp + 64 * kk), v1 = *(const u32x4*)(xp + 64 * kk + 8);
#pragma unroll
                for (int j = 0; j < 4; ++j) { xa[kk][j] = v0[j]; xa[kk][4 + j] = v1[j]; }
#pragma unroll
                for (int j = 0; j < 4; ++j) { const unsigned w0 = xa[kk][j], w1 = xa[kk][4 + j];
                    const f16x2 p0 = __builtin_bit_cast(f16x2, w0), p1 = __builtin_bit_cast(f16x2, w1);
                    ss = __builtin_amdgcn_fdot2(p0, p0, ss, false); ss2 = __builtin_amdgcn_fdot2(p1, p1, ss2, false); }
            }
            ss += ss2;
            ss += __shfl_xor(ss, 16); ss += __shfl_xor(ss, 32);
            const float rs = rsqrtf(ss * (1.f / 1024.f) + EPS);
            f32x4 acc0 = {0.f, 0.f, 0.f, 0.f}, acc1 = {0.f, 0.f, 0.f, 0.f};
            unsigned char* hp = H8 + (size_t)(t0 + lrow + fr) * 1024 + 16 * fq;
#pragma unroll
            for (int kk = 0; kk < 16; ++kk) {
                float y[16];
#pragma unroll
                for (int j = 0; j < 4; ++j) { const f32x4 s4 = *(LAS f32x4*)(mod + 64 * kk + 16 * fq + 4 * j), h4 = *(LAS f32x4*)(mod + 1024 + 64 * kk + 16 * fq + 4 * j);
                    const f16x2 p0 = __builtin_bit_cast(f16x2, xa[kk][2 * j]), p1 = __builtin_bit_cast(f16x2, xa[kk][2 * j + 1]);
                    y[4 * j + 0] = (float)p0[0] * rs * s4[0] + h4[0]; y[4 * j + 1] = (float)p0[1] * rs * s4[1] + h4[1];
                    y[4 * j + 2] = (float)p1[0] * rs * s4[2] + h4[2]; y[4 * j + 3] = (float)p1[1] * rs * s4[3] + h4[3]; }
                u32x4 o8;
#pragma unroll
                for (int j = 0; j < 4; ++j) o8[j] = pk4f8(y[4 * j], y[4 * j + 1], y[4 * j + 2], y[4 * j + 3]);
                *(u32x4*)(hp + 64 * kk) = o8;
                u32x4 a0w, a1w;
#pragma unroll
                for (int j = 0; j < 4; ++j) { a0w[j] = pkh(y[2 * j], y[2 * j + 1]); a1w[j] = pkh(y[8 + 2 * j], y[8 + 2 * j + 1]); }
                const f16x8 a0 = __builtin_bit_cast(f16x8, a0w), a1 = __builtin_bit_cast(f16x8, a1w);
                LAS const unsigned char* wp = wl + fr * WPITCH + (64 * kk + 16 * fq) * 2;
                const f16x8 b00 = *(LAS const f16x8*)(wp), b01 = *(LAS const f16x8*)(wp + 16), b10 = *(LAS const f16x8*)(wp + 16 * WPITCH), b11 = *(LAS const f16x8*)(wp + 16 * WPITCH + 16);
                acc0 = __builtin_amdgcn_mfma_f32_16x16x32_f16(a0, b00, acc0, 0, 0, 0); acc1 = __builtin_amdgcn_mfma_f32_16x16x32_f16(a0, b10, acc1, 0, 0, 0);
                acc0 = __builtin_amdgcn_mfma_f32_16x16x32_f16(a1, b01, acc0, 0, 0, 0); acc1 = __builtin_amdgcn_mfma_f32_16x16x32_f16(a1, b11, acc1, 0, 0, 0);
            }
#pragma unroll
            for (int r = 0; r < 4; ++r) { lgt[(lrow + 4 * fq + r) * 33 + fr] = acc0[r]; lgt[(lrow + 4 * fq + r) * 33 + 16 + fr] = acc1[r]; }
        }
        __syncthreads();
        int e[4]; float gt[4]; unsigned lp[4]; const bool act = tid < 256; const int t = t0 + tid;
        if (act) {
            float lg[32];
#pragma unroll
            for (int k = 0; k < 32; ++k) lg[k] = lgt[tid * 33 + k] + b_router[k];
            float tv[4];
#pragma unroll
            for (int j = 0; j < 4; ++j) { float best = lg[0]; int bi = 0;
#pragma unroll
                for (int k = 1; k < 32; ++k) { if (lg[k] > best) { best = lg[k]; bi = k; } }
#pragma unroll
                for (int k = 0; k < 32; ++k) lg[k] = (k == bi) ? -INFINITY : lg[k];
                e[j] = bi; tv[j] = best; }
            float ps[4], sum = 0.f;
#pragma unroll
            for (int j = 0; j < 4; ++j) { ps[j] = __expf(tv[j] - tv[0]); sum += ps[j]; }
#pragma unroll
            for (int j = 0; j < 4; ++j) { gt[j] = ps[j] / sum; lp[j] = __hip_atomic_fetch_add(&hist[e[j]], 1u, __ATOMIC_RELAXED, __HIP_MEMORY_SCOPE_WORKGROUP); }
        }
        __syncthreads();
        if (tid < 32) { const unsigned c = hist[tid]; base[tid] = c ? atomicAdd(&CNT[tid], c) : 0u; }
        __syncthreads();
        if (act) {
#pragma unroll
            for (int j = 0; j < 4; ++j) { const int gg = e[j]; const unsigned pos = base[gg] + lp[j]; ROWINFO[(size_t)gg * 65536 + pos] = (u64)(unsigned)t | ((u64)__float_as_uint(gt[j]) << 32); TOKSLOT[(size_t)t * 4 + j] = ((unsigned)e[j] << 16) | pos; }
        }
    }
}
struct MoeTabs { LAS unsigned* cnt; LAS unsigned* ptile; LAS unsigned* rtg; LAS unsigned* tokt; };
__device__ __forceinline__ MoeTabs moe_tables(LAS unsigned char* aux, const unsigned* CNT, int tid, int lane, int wave, bool build = true) {
    MoeTabs m; m.cnt = (LAS unsigned*)aux; m.ptile = m.cnt + 128; m.rtg = m.cnt + 384; m.tokt = m.cnt + 2048;
    if (!build) return m;
    if (tid < 32) m.cnt[tid] = __hip_atomic_load(CNT + tid, __ATOMIC_RELAXED, __HIP_MEMORY_SCOPE_AGENT);
    __syncthreads();
    if (tid == 0) { unsigned p = 0; for (int g = 0; g < 32; ++g) { m.ptile[g] = p; p += (m.cnt[g] + 255u) >> 8; } m.ptile[32] = p; }
    __syncthreads();
    for (int g = wave; g < 32; g += 8) { const unsigned bs = m.ptile[g], n = m.ptile[g + 1] - bs; for (unsigned mt = lane; mt < n; mt += 64) m.rtg[bs + mt] = ((unsigned)g << 16) | mt; }
    __syncthreads();
    return m;
}

__device__ __forceinline__ void combine_phase(const MoeTabs& tb, const unsigned* TOKSLOT, const unsigned char* Y, const float* mod, float* out, int gw, int NGW, int lane) {
    for (int chunk = gw; chunk < T / 32; chunk += NGW) {
        f32x4 g2v[4];
#pragma unroll
        for (int k = 0; k < 4; ++k) g2v[k] = *(const f32x4*)(mod + ((chunk * 32) >> 13) * 6144 + 5120 + 16 * lane + 4 * k);
#pragma unroll 1
        for (int r = 0; r < 32; r += 4) {
            const size_t t0 = (size_t)chunk * 32 + r;
            f16x8 xh[4][2]; u32x4 yv[4][4];
#pragma unroll
            for (int i = 0; i < 4; ++i) {
                const size_t t = t0 + i;
                const u32x4 ts = *(const u32x4*)(TOKSLOT + t * 4);
                const h16* xp = (const h16*)out + t * 2048 + 1024 + 16 * lane;
                xh[i][0] = *(const f16x8*)xp; xh[i][1] = *(const f16x8*)(xp + 8);
                const unsigned v0 = ts[0], v1 = ts[1], v2 = ts[2], v3 = ts[3];
                yv[i][0] = *(const u32x4*)(Y + ((size_t)tb.ptile[v0 >> 16] * 256 + (v0 & 0xffffu)) * 1024 + 16 * lane);
                yv[i][1] = *(const u32x4*)(Y + ((size_t)tb.ptile[v1 >> 16] * 256 + (v1 & 0xffffu)) * 1024 + 16 * lane);
                yv[i][2] = *(const u32x4*)(Y + ((size_t)tb.ptile[v2 >> 16] * 256 + (v2 & 0xffffu)) * 1024 + 16 * lane);
                yv[i][3] = *(const u32x4*)(Y + ((size_t)tb.ptile[v3 >> 16] * 256 + (v3 & 0xffffu)) * 1024 + 16 * lane);
            }
            asm volatile("s_waitcnt vmcnt(0)" ::: "memory");
#pragma unroll
            for (int i = 0; i < 4; ++i) {
                unsigned yw[4][4];
#pragma unroll
                for (int j = 0; j < 4; ++j) { yw[j][0] = yv[i][j].x; yw[j][1] = yv[i][j].y; yw[j][2] = yv[i][j].z; yw[j][3] = yv[i][j].w; }
#pragma unroll
                for (int k = 0; k < 4; ++k) {
                    f32x4 s = {0.f, 0.f, 0.f, 0.f}, xv;
#pragma unroll
                    for (int q = 0; q < 4; ++q) xv[q] = (float)xh[i][k >> 1][(k & 1) * 4 + q];
#pragma unroll
                    for (int j = 0; j < 4; ++j) { const f32x2 lo = __builtin_amdgcn_cvt_pk_f32_bf8((int)yw[j][k], false), hi = __builtin_amdgcn_cvt_pk_f32_bf8((int)yw[j][k], true);
                        s[0] += lo[0]; s[1] += lo[1]; s[2] += hi[0]; s[3] += hi[1]; }
                    *(f32x4*)(out + (t0 + i) * 1024 + 16 * lane + 4 * k) = xv + g2v[k] * s; }
            }
        }
    }
}

#ifndef MK_LAUNCHES
#define MK_LAUNCHES 1
#endif
constexpr int NPH = 10;
struct Args { const float* in[26]; float* out; unsigned char* ws; int ph_lo, ph_hi, li, use_bar; };

__global__ void __launch_bounds__(512, 2) hybrid_fwd(Args a) {
    extern __shared__ __attribute__((aligned(16))) unsigned char lds_raw[];
    LAS unsigned char* lds = (LAS unsigned char*)lds_raw;
    volatile LAS unsigned* MISC = (volatile LAS unsigned*)(lds + MISC_OFF);
    const int G = gridDim.x, bx = blockIdx.x;
    const int vcu = (G % 8 == 0) ? (bx % 8) * (G / 8) + bx / 8 : bx;
    const int NGW = G * 8;
#define PHASE_IDS() int tid = threadIdx.x; asm volatile("" : "+v"(tid)); const int lane = tid & 63, wave = __builtin_amdgcn_readfirstlane(tid >> 6); const int gw = vcu * 8 + wave; (void)lane; (void)gw
    if (threadIdx.x < 64) MISC[threadIdx.x] = 0u;
    __syncthreads();
    unsigned char* ws = a.ws;
    unsigned* ctl = (unsigned*)(ws + WS_CTL);
    XcdBarrier bar; bar.bar = ctl + CW_BAR + a.li * XCD_BAR_WORDS; bar.x = 0; bar.st = nullptr;
    if (a.use_bar) bar = xcd_barrier_post(ctl + CW_BAR + a.li * XCD_BAR_WORDS, MISC + 8);
    const int lo = a.ph_lo, hi = a.ph_hi;
#ifndef ONLY_PHASE
#define ONLY_PHASE -1
#endif
#define PEN(k) (ONLY_PHASE < 0 || ONLY_PHASE == (k) || (ONLY_PHASE / 10 == (k) && ONLY_PHASE >= 30))
#define SUBEN(k) (ONLY_PHASE < 30 || ONLY_PHASE == (k))
#define IN(k) (PEN(k) && lo <= (k) && (k) < hi)
#define SEAM(k) do { if (IN(k) && IN((k) + 1)) xcd_barrier(bar); } while (0)
#define DUP(k) _Pragma("unroll 1") for (int rep_ = 0; rep_ < ((PROBE_DUP == (k)) ? 2 : 1); ++rep_)
#define DUPBAR(k) do { if (PROBE_DUP == (k) && rep_ == 0) xcd_barrier(bar); } while (0)
    float* const out = a.out;
#define INP(i) (a.in[i])
#define WSP(T_, off) ((T_*)(ws + (off)))
    unsigned* const CNT = ctl + CW_CNT;

    if (IN(0)) DUP(0) {
        PHASE_IDS();
        mod_phase(lds, INP(1), INP(2), INP(3), WSP(float, WS_MOD), tid, G);
        asm volatile("s_waitcnt vmcnt(0)" ::: "memory");
        __syncthreads();
        if (tid == 0) { __builtin_amdgcn_fence(__ATOMIC_RELEASE, "agent"); asm volatile("s_waitcnt vmcnt(0)" ::: "memory"); (void)xb_add(ctl + 16, 1u); }
        P0Args pa{INP(5), INP(18), INP(16), INP(17), INP(22), INP(24), INP(20), INP(8), INP(10), WSP(h16, WS_WIN), WSP(h16, WS_WOUT), WSP(unsigned char, WS_W1), WSP(unsigned char, WS_W2), WSP(h16, WS_WROUT), WSP(h16, WS_WRG)};
        convert_phase(lds, pa, tid, lane, wave, gw, NGW, 0);
        DUPBAR(0);
    }
    if (IN(0) && IN(1)) {
        if (threadIdx.x == 0) { unsigned sp_ = 0u; while (xb_ld(ctl + 16) < (unsigned)G) { __builtin_amdgcn_s_sleep(1); if (++sp_ > (1u << 22)) break; }
            __builtin_amdgcn_fence(__ATOMIC_ACQUIRE, "agent"); asm volatile("s_waitcnt vmcnt(0)" ::: "memory"); }
        __syncthreads();
    }
    if (IN(1)) { PHASE_IDS(); rmsnorm_rows(INP(0), WSP(h16, WS_A), nullptr, INP(4), WSP(float, WS_MOD) + 1024, WSP(float, WS_MOD), gw, NGW, lane); }
    SEAM(1);
    if (IN(2)) DUP(2) {
        pg8::StaticOrder S; S.init(T, NIN_TILES * 256, G, bx);
        pg8::EpiInProj E{WSP(u16, WS_XR), WSP(h16, WS_KI), WSP(float, WS_WI), INP(13), INP(14), INP(15)};
        pg8::gemm_phase<pg8::EpiInProj, pg8::StaticOrder, true, 0>(lds + RING_OFF, WSP(h16, WS_A), WSP(h16, WS_WIN), 1024, S, E);
        DUPBAR(2);
    }
    SEAM(2);
    if (IN(3)) {
        if (SUBEN(30)) DUP(30) { PHASE_IDS();
        rg_phase(lds, WSP(h16, WS_XR), INP(6), INP(7), WSP(h16, WS_WRG), INP(9), INP(11), INP(12), WSP(h16, WS_HL), WSP(h16, WS_AC), WSP(float, WS_SUMP), WSP(float, WS_SUMH), tid, lane, wave, G); DUPBAR(30); }
        __syncthreads();
        if (SUBEN(31)) DUP(31) { PHASE_IDS();
        if (wave < 4) __builtin_amdgcn_s_setprio(1);
        idx_phase(lds, WSP(h16, WS_QI), WSP(h16, WS_KI), WSP(float, WS_WI), WSP(unsigned, WS_MASK), WSP(unsigned char, WS_A), tid, lane, wave, G);     __builtin_amdgcn_s_setprio(0); DUPBAR(31); }
    }
    SEAM(3);
    if (IN(4)) {
        if (SUBEN(40)) DUP(40) { PHASE_IDS();
        r3_phase(lds, WSP(h16, WS_HL), WSP(h16, WS_AC), WSP(h16, WS_XG), WSP(float, WS_SUMP), WSP(float, WS_SUMH), WSP(h16, WS_A), tid, lane, wave, G); DUPBAR(40); }
        __syncthreads();
        if (SUBEN(41)) DUP(41) {
        const attn_body::AttnTensors AT{WSP(const attn_body::bf16, WS_Q), WSP(const attn_body::bf16, WS_K), WSP(const attn_body::bf16, WS_V), WSP(_Float16, WS_A), WSP(const unsigned, WS_MASK), WSP(float, WS_SSQ8)};
        const attn_body::StaticOrder S(G, bx);
        const bool csplit = (G % 16 == 0);
        const int cgrp = csplit ? ((bx >> 3) & 1) : 0;
        const int cbase = csplit ? 16 * ((bx & 7) + 8 * (bx >> 4)) + cgrp : 8 * bx, cstep = csplit ? 2 : 1;
        const P0Args pb{INP(5), INP(18), INP(16), INP(17), INP(22), INP(24), INP(20), INP(8), INP(10), WSP(h16, WS_WIN), WSP(h16, WS_WOUT), WSP(unsigned char, WS_W1), WSP(unsigned char, WS_W2), WSP(h16, WS_WROUT), WSP(h16, WS_WRG)};
        if (cgrp == 0) { PHASE_IDS(); convert_phase(lds, pb, tid, lane, wave, cbase + cstep * wave, NGW, 1); asm volatile("s_waitcnt vmcnt(0) lgkmcnt(0)" ::: "memory"); __syncthreads(); }
        attn_body::attn_phase<attn_body::StaticOrder>((char*)lds_raw + RING_OFF, AT, S);
        if (cgrp != 0) { PHASE_IDS(); asm volatile("s_waitcnt vmcnt(0) lgkmcnt(0)" ::: "memory"); __syncthreads(); convert_phase(lds, pb, tid, lane, wave, cbase + cstep * wave, NGW, 1); }
        DUPBAR(41); }
    }
    SEAM(4);
    if (IN(5)) DUP(5) {
        pg8::StaticOrder S; S.init(T, 1024, G, bx);
        LAS float* rl = (LAS float*)(lds + AUX_OFF);
        { PHASE_IDS(); pg8::Unit u; const float* ssq = WSP(float, WS_SSQ8);
          for (int i = 0; i < 16 && S.next(i, u); ++i) {
              if (tid < 256) { const size_t row = (size_t)u.pm * 256 + tid; const f32x4 s0 = *(const f32x4*)(ssq + row * 8), s1 = *(const f32x4*)(ssq + row * 8 + 4);
                  rl[i * 256 + tid] = rsqrtf((((s0[0] + s0[1]) + (s0[2] + s0[3])) + ((s1[0] + s1[1]) + (s1[2] + s1[3]))) * (1.f / 512.f) + EPS); } }
          __syncthreads(); }
        pg8::EpiOutProj E{INP(0), out, WSP(float, WS_MOD), rl};
        pg8::gemm_phase<pg8::EpiOutProj, pg8::StaticOrder, true, 8>(lds + RING_OFF, WSP(h16, WS_A), WSP(h16, WS_WOUT), 1024, S, E);
        DUPBAR(5);
    }
    SEAM(5);
    if (IN(6)) { PHASE_IDS();
        norm_route_phase(lds, out, WSP(unsigned char, WS_H8), INP(19), WSP(float, WS_MOD) + 4096, WSP(float, WS_MOD) + 3072, WSP(h16, WS_WROUT), INP(21), CNT, WSP(u64, WS_ROWINFO), WSP(unsigned, WS_TOKSLOT), tid, lane, wave, G, vcu);
    }
    SEAM(6);
    if (IN(7)) DUP(9) {
        PHASE_IDS();
        const MoeTabs tb = moe_tables(lds + AUX_OFF, CNT, tid, lane, wave);
        const int nrt = (int)tb.ptile[32];
        const int cpx = (G % 32 == 0) ? 32 : 8, ngrp = G / cpx;
        pg8::MoeSched<true> S{nrt, 0, 8, cpx / 8, ngrp, bx % ngrp, (bx / ngrp) % cpx, 2048, tb.rtg, (LAS const u16*)tb.tokt};
        { pg8::Unit u; LAS u16* tk = (LAS u16*)tb.tokt;
          for (int i = 0; i < 40 && S.next(i, u); ++i) {
              if (tid < 256) { const int g = (u.aux >> 16) & 127, mt = u.aux & 0xffff; const int idx = mt * 256 + tid;
                  tk[i * 256 + tid] = idx < (int)tb.cnt[g] ? (u16)(unsigned)WSP(u64, WS_ROWINFO)[(size_t)g * 65536 + idx] : (u16)0; } } }
        __syncthreads();
        pg8::EpiGemm1 E{WSP(unsigned char, WS_ACT), INP(23)};
        pg8::gemm_phase<pg8::EpiGemm1, pg8::MoeSched<true>, true, 0, true>(lds + RING_OFF, WSP(unsigned char, WS_H8), WSP(unsigned char, WS_W1), 1024, S, E);
        DUPBAR(9);
    }
    SEAM(7);
    if (IN(8)) {
        PHASE_IDS();
        const MoeTabs tb = moe_tables(lds + AUX_OFF, CNT, tid, lane, wave, !IN(7));
        const int nrt = (int)tb.ptile[32];
        const int cpx = (G % 32 == 0) ? 32 : 4, ngrp = G / cpx;
        pg8::MoeSched<false> S{nrt, 0, 4, cpx / 4, ngrp, bx % ngrp, (bx / ngrp) % cpx, 1024, tb.rtg, (LAS const u16*)tb.tokt};
        LAS unsigned* rtab = (LAS unsigned*)tb.tokt;
        { pg8::Unit u;
          for (int i = 0; i < 20 && S.next(i, u); ++i) {
              if (tid < 256) { const int g = (u.aux >> 16) & 127, mt = u.aux & 0xffff; const int idx = mt * 256 + tid; unsigned v = 0u;
                  if (idx < (int)tb.cnt[g]) { const u64 ri = WSP(u64, WS_ROWINFO)[(size_t)g * 65536 + idx]; v = ((unsigned)ri & 0xffffu) | (pkh(0.f, __uint_as_float((unsigned)(ri >> 32))) & 0xffff0000u); }
                  rtab[i * 256 + tid] = v; } } }
        __syncthreads();
        pg8::EpiGemm2 E{WSP(unsigned char, WS_Y), INP(25), rtab, tb.cnt};
        pg8::gemm_phase<pg8::EpiGemm2, pg8::MoeSched<false>, true, 0, true>(lds + RING_OFF, WSP(unsigned char, WS_ACT), WSP(unsigned char, WS_W2), 1024, S, E);
    }
    SEAM(8);
    if (IN(9)) {
        PHASE_IDS();
        const MoeTabs tb = moe_tables(lds + AUX_OFF, CNT, tid, lane, wave, !IN(7));
        combine_phase(tb, WSP(unsigned, WS_TOKSLOT), WSP(unsigned char, WS_Y), WSP(float, WS_MOD), out, gw, NGW, lane);
    }
#undef IN
#undef SEAM
}

extern "C" void kernel_launch(void* const* d_in, const int* in_sizes, int n_in, void* d_out, int out_size, void* d_ws, size_t ws_size, hipStream_t stream) {
    static int grid = 0;
    if (grid == 0) {
        if (n_in != 26 || out_size != T * D || ws_size < WS_END) { fprintf(stderr, "kernel_launch: unexpected shapes (n_in %d, out %d, ws %zu)\n", n_in, out_size, ws_size); grid = -1; return; }
        int dev = 0, cus = 0, per_cu = 0;
        if (hipGetDevice(&dev) != hipSuccess || hipDeviceGetAttribute(&cus, hipDeviceAttributeMultiprocessorCount, dev) != hipSuccess) { grid = -1; return; }
        if (hipFuncSetAttribute((const void*)hybrid_fwd, hipFuncAttributeMaxDynamicSharedMemorySize, LDS_BYTES) != hipSuccess) { fprintf(stderr, "kernel_launch: hipFuncSetAttribute failed\n"); grid = -1; return; }
        if (hipOccupancyMaxActiveBlocksPerMultiprocessor(&per_cu, (const void*)hybrid_fwd, 512, LDS_BYTES) != hipSuccess || per_cu < 1) fprintf(stderr, "kernel_launch: occupancy query says %d\n", per_cu);
        (void)hipGetLastError();
        if (cus < 64) { fprintf(stderr, "kernel_launch: %d CUs (needs >= 64)\n", cus); grid = -1; return; }
        grid = cus < 256 ? cus : 256;
    }
    if (grid < 0) return;
    if (hipMemsetAsync((char*)d_ws + WS_CTL, 0, CTL_ZERO_BYTES, stream) != hipSuccess) return;
    Args a{};
    for (int i = 0; i < 26; ++i) a.in[i] = (const float*)d_in[i];
    a.out = (float*)d_out; a.ws = (unsigned char*)d_ws;
#if MK_LAUNCHES == 1
    a.ph_lo = 0; a.ph_hi = NPH; a.li = 0; a.use_bar = 1;
    hipLaunchKernelGGL(hybrid_fwd, dim3(grid), dim3(512), LDS_BYTES, stream, a);
#else
    for (int p = 0; p < NPH; ++p) { a.ph_lo = p; a.ph_hi = p + 1; a.li = 0; a.use_bar = 0; hipLaunchKernelGGL(hybrid_fwd, dim3(grid), dim3(512), LDS_BYTES, stream, a); }
#endif
}
```
